# Optimizing an MI355X kernel written in HIP

```python
import jax, jax.numpy as jnp
from jax import lax
import numpy as np

D_MODEL = 1024
BATCH = 4
SEQ = 4096
DEPTH = 2

N_A_LAYERS = DEPTH // 2
N_B_LAYERS = DEPTH - N_A_LAYERS

D_FF = 2816
RMS_EPS = 1e-6

RWKV_HEAD = 64
RWKV_HEADS = D_MODEL // RWKV_HEAD
DECAY_LORA = 64
AAA_LORA = 64
GATE_LORA = 128
GN_EPS = 64e-5

ATT_HEAD = 64
Q_HEADS = D_MODEL // ATT_HEAD
KV_HEADS = 4
GROUP = Q_HEADS // KV_HEADS
WINDOW = 128
BLOCK = 128
KV_WIDTH = KV_HEADS * ATT_HEAD
MASK_VALUE = -1e30

kernel_name = "yoco_rwkv7_swa_sink_macaron"


def rms_norm(x, g):
    xf = x.astype(jnp.float32)
    y = xf * lax.rsqrt(jnp.mean(xf * xf, axis=-1, keepdims=True) + RMS_EPS)
    return (y * g.astype(jnp.float32)).astype(x.dtype)


def swiglu(x, w_in, w_out):
    gate, up = jnp.split(x @ w_in, 2, axis=-1)
    return (jax.nn.silu(gate) * up) @ w_out


def rwkv7_time_mix(x, mu, w_rkv, w_o, w0, w1, w2, a0, a1, a2, g1, g2,
                   k_k, k_a, r_k, gn_g, gn_b):
    B, T, C = x.shape
    H, N = RWKV_HEADS, RWKV_HEAD
    f32 = jnp.float32
    x_prev = jnp.pad(x, ((0, 0), (1, 0), (0, 0)))[:, :-1]
    xx = x_prev - x
    xr, xw, xk, xv, xa, xg = [x + xx * mu[i] for i in range(6)]

    r = xr @ w_rkv[0]
    k = xk @ w_rkv[1]
    v = xv @ w_rkv[2]
    w = -jax.nn.softplus(-(w0 + jnp.tanh(xw @ w1) @ w2)) - 0.5
    decay = jnp.exp(-jnp.exp(w.astype(f32)))
    a = jax.nn.sigmoid(a0 + (xa @ a1) @ a2)
    g = jax.nn.sigmoid(xg @ g1) @ g2

    heads = lambda t: t.reshape(B, T, H, N).astype(f32)
    kk = heads(k * k_k)
    kk = kk / jnp.maximum(jnp.linalg.norm(kk, axis=-1, keepdims=True), 1e-12)
    k = k * (1.0 + (a - 1.0) * k_a)
    r_h, k_h, v_h, a_h, w_h = heads(r), heads(k), heads(v), heads(a), heads(decay)
    b_h = kk * a_h

    def step(S, inp):
        r_t, w_t, k_t, v_t, kk_t, b_t = inp
        sa = jnp.einsum('bhij,bhj->bhi', S, -kk_t)
        S = (S * w_t[:, :, None, :] + sa[..., None] * b_t[:, :, None, :]
             + v_t[..., None] * k_t[:, :, None, :])
        y = jnp.einsum('bhij,bhj->bhi', S, r_t)
        return S, y

    xs = tuple(jnp.moveaxis(t, 1, 0) for t in (r_h, w_h, k_h, v_h, kk, b_h))
    S0 = jnp.zeros((B, H, N, N), f32)
    _, y = lax.scan(step, S0, xs)
    y = jnp.moveaxis(y, 0, 1)

    mean = jnp.mean(y, axis=-1, keepdims=True)
    var = jnp.mean(jnp.square(y - mean), axis=-1, keepdims=True)
    y = ((y - mean) * lax.rsqrt(var + GN_EPS)).reshape(B, T, C)
    y = y * gn_g.astype(f32) + gn_b.astype(f32)
    bonus = jnp.sum(r_h * k_h * r_k.astype(f32), axis=-1, keepdims=True) * v_h
    y = (y + bonus.reshape(B, T, C)).astype(x.dtype)
    return (y * g) @ w_o


def swa_sinks(xq, k_sh, v_sh, w_q, b_q, w_o, b_o, sinks):
    B, T, _ = xq.shape
    NB = T // BLOCK
    q = (xq @ w_q + b_q).reshape(B, NB, BLOCK, KV_HEADS, GROUP, ATT_HEAD)

    def banded(t):
        t = t.reshape(B, NB, BLOCK, KV_HEADS, ATT_HEAD)
        prev = jnp.pad(t, ((0, 0), (1, 0), (0, 0), (0, 0), (0, 0)))[:, :-1]
        return jnp.concatenate([prev, t], axis=2)

    kb, vb = banded(k_sh), banded(v_sh)
    s = jnp.einsum('bnqkgd,bnskd->bnkgqs', q, kb).astype(jnp.float32) * (ATT_HEAD ** -0.5)
    blk = jnp.arange(NB)[:, None, None] * BLOCK
    q_pos = blk + jnp.arange(BLOCK)[None, :, None]
    k_pos = blk - BLOCK + jnp.arange(2 * BLOCK)[None, None, :]
    valid = (k_pos >= 0) & (k_pos <= q_pos) & (q_pos - k_pos < WINDOW)
    s = jnp.where(valid[None, :, None, None], s, MASK_VALUE)
    sink = jnp.broadcast_to(
        sinks.astype(jnp.float32).reshape(1, 1, KV_HEADS, GROUP, 1, 1), s.shape[:-1] + (1,))
    p = jax.nn.softmax(jnp.concatenate([s, sink], axis=-1), axis=-1)[..., :-1]
    o = jnp.einsum('bnkgqs,bnskd->bnqkgd', p.astype(vb.dtype), vb)
    o = o.reshape(B, T, Q_HEADS * ATT_HEAD)
    return o @ w_o + b_o


def setup_inputs(seed: int = 0) -> dict:
    key = jax.random.key(seed)
    ks = iter(jax.random.split(key, 32))
    D, NA, NBL = D_MODEL, N_A_LAYERS, N_B_LAYERS
    f32 = jnp.float32

    def nrm(shape, scale):
        return scale * jax.random.normal(next(ks), shape, f32)

    def uni(shape, lo, hi):
        return jax.random.uniform(next(ks), shape, f32, lo, hi)

    return {
        "x": nrm((BATCH, SEQ, D), 1.0),
        "norm_g": 1.0 + nrm((DEPTH, 6, D), 0.05),
        "ffn_w_in": nrm((DEPTH, 2, D, 2 * D_FF), D ** -0.5),
        "ffn_w_out": nrm((DEPTH, 2, D_FF, D), D_FF ** -0.5),
        "rwkv_mu": uni((NA, 6, D), 0.0, 1.0),
        "rwkv_w_rkv": nrm((NA, 3, D, D), D ** -0.5),
        "rwkv_w_o": nrm((NA, D, D), D ** -0.5),
        "rwkv_w0": uni((NA, D), -6.0, -1.0),
        "rwkv_w1": nrm((NA, D, DECAY_LORA), D ** -0.5),
        "rwkv_w2": nrm((NA, DECAY_LORA, D), 0.1 * DECAY_LORA ** -0.5),
        "rwkv_a0": nrm((NA, D), 0.1),
        "rwkv_a1": nrm((NA, D, AAA_LORA), D ** -0.5),
        "rwkv_a2": nrm((NA, AAA_LORA, D), 0.1 * AAA_LORA ** -0.5),
        "rwkv_g1": nrm((NA, D, GATE_LORA), D ** -0.5),
        "rwkv_g2": nrm((NA, GATE_LORA, D), GATE_LORA ** -0.5),
        "rwkv_k_k": 0.85 + nrm((NA, D), 0.05),
        "rwkv_k_a": 1.0 + nrm((NA, D), 0.05),
        "rwkv_r_k": nrm((NA, RWKV_HEADS, RWKV_HEAD), 0.1),
        "rwkv_gn_g": 1.0 + nrm((NA, D), 0.05),
        "rwkv_gn_b": nrm((NA, D), 0.02),
        "kv_norm_g": 1.0 + nrm((D,), 0.05),
        "w_kv": nrm((D, 2 * KV_WIDTH), D ** -0.5),
        "b_kv": nrm((2 * KV_WIDTH,), 0.02),
        "attn_w_q": nrm((NBL, D, Q_HEADS * ATT_HEAD), D ** -0.5),
        "attn_b_q": nrm((NBL, Q_HEADS * ATT_HEAD), 0.02),
        "attn_w_o": nrm((NBL, Q_HEADS * ATT_HEAD, D), (Q_HEADS * ATT_HEAD) ** -0.5),
        "attn_b_o": nrm((NBL, D), 0.02),
        "attn_sinks": nrm((NBL, Q_HEADS), 1.0),
    }


def reference(x, norm_g, ffn_w_in, ffn_w_out,
              rwkv_mu, rwkv_w_rkv, rwkv_w_o, rwkv_w0, rwkv_w1, rwkv_w2,
              rwkv_a0, rwkv_a1, rwkv_a2, rwkv_g1, rwkv_g2, rwkv_k_k, rwkv_k_a,
              rwkv_r_k, rwkv_gn_g, rwkv_gn_b,
              kv_norm_g, w_kv, b_kv,
              attn_w_q, attn_b_q, attn_w_o, attn_b_o, attn_sinks):
    B, T, _ = x.shape
    h = x
    k_sh = v_sh = None
    for layer in range(DEPTH):
        g = norm_g[layer]
        h = h + 0.5 * rms_norm(swiglu(rms_norm(h, g[0]), ffn_w_in[layer, 0], ffn_w_out[layer, 0]), g[1])
        u = rms_norm(h, g[2])
        if layer < N_A_LAYERS:
            i = layer
            m = rwkv7_time_mix(u, rwkv_mu[i], rwkv_w_rkv[i], rwkv_w_o[i], rwkv_w0[i],
                               rwkv_w1[i], rwkv_w2[i], rwkv_a0[i], rwkv_a1[i], rwkv_a2[i],
                               rwkv_g1[i], rwkv_g2[i], rwkv_k_k[i], rwkv_k_a[i],
                               rwkv_r_k[i], rwkv_gn_g[i], rwkv_gn_b[i])
        else:
            j = layer - N_A_LAYERS
            m = swa_sinks(u, k_sh, v_sh, attn_w_q[j], attn_b_q[j], attn_w_o[j],
                          attn_b_o[j], attn_sinks[j])
        h = h + rms_norm(m, g[3])
        h = h + 0.5 * rms_norm(swiglu(rms_norm(h, g[4]), ffn_w_in[layer, 1], ffn_w_out[layer, 1]), g[5])
        if layer == N_A_LAYERS - 1:
            kv = rms_norm(h, kv_norm_g) @ w_kv + b_kv
            k_sh = kv[..., :KV_WIDTH].reshape(B, T, KV_HEADS, ATT_HEAD)
            v_sh = kv[..., KV_WIDTH:].reshape(B, T, KV_HEADS, ATT_HEAD)
    return h
```

```cpp
#include <hip/hip_runtime.h>
#include <hip/hip_cooperative_groups.h>
#include <cstdio>
#include <cstdint>
namespace cg = cooperative_groups;

#define LAS __attribute__((address_space(3)))
typedef unsigned short bf16_t;
typedef short bf16x8 __attribute__((ext_vector_type(8)));
typedef short bf16x4 __attribute__((ext_vector_type(4)));
typedef float f32x4 __attribute__((ext_vector_type(4)));
typedef float f32x2 __attribute__((ext_vector_type(2)));
typedef unsigned u32x4 __attribute__((ext_vector_type(4)));
typedef unsigned u32x2 __attribute__((ext_vector_type(2)));

constexpr int T_ = 4096, D_ = 1024, M_ = 16384, FF_ = 2816;
constexpr float RMS_EPS = 1e-6f, GN_EPS = 64e-5f;
constexpr float LOG2E = 1.4426950408889634f;
constexpr float QSCALE = 0.125f * LOG2E;
constexpr int NWAVES = 8, NTHR = 512;
constexpr int LDS_BYTES = 135168;

constexpr size_t MiB = 1u << 20;
constexpr size_t WS_WIN = 1 * MiB;
constexpr size_t WIN_STRIDE = 11 * MiB;
constexpr size_t WS_WOUT = 45 * MiB;
constexpr size_t WOUT_STRIDE = 5 * MiB + MiB / 2;
constexpr size_t WS_B3 = 67 * MiB;
constexpr size_t WS_LUP = 74 * MiB + MiB / 2;
constexpr size_t WS_RWO = 76 * MiB;
constexpr size_t WS_WKV = 78 * MiB;
constexpr size_t WS_WQ = 79 * MiB;
constexpr size_t WS_AWO = 81 * MiB;
constexpr size_t WS_F = 84 * MiB;
constexpr size_t WS_XN = 116 * MiB;
constexpr size_t WS_HID = 148 * MiB;
constexpr size_t WS_KB = 236 * MiB;
constexpr size_t WS_VT = 244 * MiB;
constexpr size_t WS_Q = 252 * MiB;
constexpr size_t WS_O = 284 * MiB;
constexpr size_t WS_X6 = 148 * MiB;
constexpr size_t WS_RKV = 244 * MiB;
constexpr size_t WS_LD = 340 * MiB;
constexpr size_t WS_DEC = 148 * MiB;
constexpr size_t WS_A = 180 * MiB;
constexpr size_t WS_G = 212 * MiB;
constexpr size_t WS_Y = 84 * MiB;
constexpr size_t WS_YG = 148 * MiB;
constexpr size_t WS_END = 352 * MiB;

__device__ __forceinline__ unsigned cvt_pk_bf16(float lo, float hi) { unsigned r; asm volatile("v_cvt_pk_bf16_f32 %0, %1, %2" : "=v"(r) : "v"(lo), "v"(hi)); return r; }
__device__ __forceinline__ float bf_lo(unsigned w) { return __builtin_bit_cast(float, w << 16); }
__device__ __forceinline__ float bf_hi(unsigned w) { return __builtin_bit_cast(float, w & 0xffff0000u); }
__device__ __forceinline__ f32x4 ld_bf4(const bf16_t* p) { const u32x2 w = *(const u32x2*)p; return (f32x4){bf_lo(w.x), bf_hi(w.x), bf_lo(w.y), bf_hi(w.y)}; }
__device__ __forceinline__ void st_bf4(bf16_t* p, f32x4 v) { u32x2 w; w.x = cvt_pk_bf16(v[0], v[1]); w.y = cvt_pk_bf16(v[2], v[3]); *(u32x2*)p = w; }
__device__ __forceinline__ void st_bf8(bf16_t* p, f32x4 v0, f32x4 v1) { u32x4 w; w.x = cvt_pk_bf16(v0[0], v0[1]); w.y = cvt_pk_bf16(v0[2], v0[3]); w.z = cvt_pk_bf16(v1[0], v1[1]); w.w = cvt_pk_bf16(v1[2], v1[3]); *(u32x4*)p = w; }
#define DPP_ADD(x, ctrl) x += __builtin_bit_cast(float, __builtin_amdgcn_update_dpp(0, __builtin_bit_cast(int, x), ctrl, 0xF, 0xF, true))
__device__ __forceinline__ float rowsum16(float x) { DPP_ADD(x, 0xB1); DPP_ADD(x, 0x4E); DPP_ADD(x, 0x141); DPP_ADD(x, 0x140); return x; }
__device__ __forceinline__ float rdlane(float x, int l) { return __builtin_bit_cast(float, __builtin_amdgcn_readlane(__builtin_bit_cast(int, x), l)); }
__device__ __forceinline__ float wave_sum(float v) { v = rowsum16(v); return (rdlane(v, 0) + rdlane(v, 16)) + (rdlane(v, 32) + rdlane(v, 48)); }
__device__ __forceinline__ float xlane(float x, int srclane) { return __builtin_bit_cast(float, __builtin_amdgcn_ds_bpermute(srclane << 2, __builtin_bit_cast(int, x))); }
__device__ __forceinline__ float fast_exp(float x) { return __builtin_amdgcn_exp2f(x * LOG2E); }
__device__ __forceinline__ float fast_sigmoid(float x) { return __builtin_amdgcn_rcpf(1.0f + fast_exp(-x)); }
__device__ __forceinline__ float fast_tanh(float x) { return 1.0f - 2.0f * __builtin_amdgcn_rcpf(fast_exp(2.0f * x) + 1.0f); }

enum { I_X = 0, I_NORMG, I_WIN, I_WOUT, I_MU, I_WRKV, I_RWO, I_W0, I_W1, I_W2, I_A0, I_A1, I_A2, I_G1, I_G2, I_KK, I_KA, I_RK, I_GNG, I_GNB, I_KVG, I_WKV, I_BKV, I_WQ, I_BQ, I_AWO, I_BO, I_SINK };
constexpr int PTAB_OFF = 131072;
__device__ __forceinline__ unsigned long long ldp(volatile LAS unsigned long long* t, int i) {
    const unsigned long long v = t[i];
    const unsigned lo = __builtin_amdgcn_readfirstlane((unsigned)v), hi = __builtin_amdgcn_readfirstlane((unsigned)(v >> 32));
    return ((unsigned long long)hi << 32) | lo;
}
#define INP(i) ((const float*)ldp(ptab, (i)))
#define WSP() ((unsigned char*)ldp(ptab, 29))
namespace pg8 {
constexpr int BM = 256, BK = 64, HALF = 128, HTB = HALF * BK * 2, STAGE_BYTES = 8 * HTB, NXCD = 8, WGM = 8;
__host__ __device__ __forceinline__ int lds_byte(int r, int c) { const int st = (r >> 4) * 2 + (c >> 5), rr = r & 15, cc = c & 31, ob = rr * 64 + cc * 2; return st * 1024 + (ob ^ (((ob >> 9) & 1) << 5)); }
__host__ __device__ __forceinline__ void stage_rc(int b, int& R, int& C) { const int st = b / 1024, sb = b % 1024, swz = sb ^ (((sb >> 9) & 1) << 5); R = (st >> 1) * 16 + swz / 64; C = (st & 1) * 32 + (swz % 64) / 2; }
__host__ __device__ __forceinline__ int perm32(int rho) { const int n = rho >> 4, i = rho & 15; return 8 * (i >> 2) + 4 * n + (i & 3); }

struct Unit { int pm, pn; };
struct Gemm { const bf16_t* A; const bf16_t* Bt; int M, N, K, lda; };

struct StaticOrder {
    int nM, nN, nwg, G, c;
    __device__ void init(int M, int N, int G_, int c_) { nM = M / BM; nN = N / BM; nwg = nM * nN; G = G_; c = c_; }
    __device__ bool next(int i, Unit& u) const {
        const long L = (long)i * G + c; if (L >= nwg) return false;
        int wgid = (int)L; { const int q = nwg / NXCD, r = nwg % NXCD, xcd = wgid % NXCD, off = wgid / NXCD; wgid = (xcd < r ? xcd * (q + 1) : r * (q + 1) + (xcd - r) * q) + off; }
        const int nig = WGM * nN, gid = wgid / nig, fm = gid * WGM, gsz = (nM - fm) < WGM ? (nM - fm) : WGM;
        u.pm = fm + ((wgid % nig) % gsz); u.pn = (wgid % nig) / gsz; return true;
    }
};

typedef f32x4 Acc[2][2][4][2];

template <class Job>
__device__ __forceinline__ void gemm_phase(LAS unsigned char* lds, const Gemm g, const StaticOrder& S, const Job& J) {
    int tid = threadIdx.x; asm volatile("" : "+v"(tid));
    const int wid = __builtin_amdgcn_readfirstlane(tid >> 6), lane = tid & 63, wr = wid >> 2, wc = wid & 3, fr = lane & 15, fq = lane >> 4;
    const int K = g.K, nt = K / BK;
    unsigned voffA[2], voffB[2];
#pragma unroll
    for (int i = 0; i < 2; ++i) { int R, C; stage_rc(tid * 16 + i * 8192, R, C); const int Rb = (R & ~31) + perm32(R & 31);
        voffA[i] = (unsigned)(R * g.lda + C) * 2u; voffB[i] = (unsigned)(Rb * K + C) * 2u; }
    const size_t kstep = (size_t)(BK * 2);
    const unsigned hstepA = (unsigned)(HALF * g.lda * 2), hstepB = (unsigned)(HALF * K * 2);
    const unsigned ldsw = (unsigned)wid * 1024u;
    const int aoff = lds_byte(wr * 64 + fr, fq * 8), boff = lds_byte(wc * 32 + fr, fq * 8);
#define PG8_SA(b, h) (((b) * 2 + (h)) * HTB)
#define PG8_SB(b, h) ((4 + (b) * 2 + (h)) * HTB)
#define PG8_STAGE(bufoff, gbase, voff) do { _Pragma("unroll") for (int _i = 0; _i < 2; ++_i) \
        __builtin_amdgcn_global_load_lds((const unsigned*)((const char*)(gbase) + (voff)[_i]), (LAS unsigned*)(lds + (bufoff) + ldsw + _i * 8192), 16, 0, 0); } while (0)
#define PG8_LDA(dst, b, h) do { _Pragma("unroll") for (int m = 0; m < 4; ++m) _Pragma("unroll") for (int k = 0; k < 2; ++k) dst[m][k] = *(const LAS bf16x8*)(lds + PG8_SA(b, h) + aoff + m * 2048 + k * 1024); } while (0)
#define PG8_LDB(dst, b, h) do { _Pragma("unroll") for (int n = 0; n < 2; ++n) _Pragma("unroll") for (int k = 0; k < 2; ++k) dst[n][k] = *(const LAS bf16x8*)(lds + PG8_SB(b, h) + boff + n * 2048 + k * 1024); } while (0)
#define PG8_MMA(ai, bj, At, Bt) do { __builtin_amdgcn_s_setprio(1); _Pragma("unroll") for (int m = 0; m < 4; ++m) _Pragma("unroll") for (int n = 0; n < 2; ++n) _Pragma("unroll") for (int k = 0; k < 2; ++k) \
        acc[ai][bj][m][n] = __builtin_amdgcn_mfma_f32_16x16x32_bf16(Bt[n][k], At[m][k], acc[ai][bj][m][n], 0, 0, 0); __builtin_amdgcn_s_setprio(0); } while (0)
#define PG8_WAIT_V(n) asm volatile("s_waitcnt vmcnt(" #n ")" ::: "memory")
#define PG8_WAIT_L(n) asm volatile("s_waitcnt lgkmcnt(" #n ")" ::: "memory")
#define PG8_BAR __builtin_amdgcn_s_barrier()
#define PG8_SCHED __builtin_amdgcn_sched_barrier(0)
    Unit cur, nxt; int ui = 0;
    if (!S.next(0, cur)) return;
    Acc acc;
#pragma unroll
    for (int a = 0; a < 2; ++a)
#pragma unroll
        for (int b = 0; b < 2; ++b)
#pragma unroll
            for (int m = 0; m < 4; ++m)
#pragma unroll
                for (int n = 0; n < 2; ++n) acc[a][b][m][n] = (f32x4){0.f, 0.f, 0.f, 0.f};
    bf16x8 At[4][2], B0[2][2], B1[2][2];
    const char* cA; const char* cB; J.ptrs(g, cur, cA, cB);
    PG8_STAGE(PG8_SB(0, 0), cB, voffB); PG8_STAGE(PG8_SB(0, 1), cB + hstepB, voffB); PG8_STAGE(PG8_SA(0, 0), cA, voffA); PG8_STAGE(PG8_SA(0, 1), cA + hstepA, voffA);
    if (wr == 1) PG8_BAR;
    PG8_WAIT_V(2); PG8_BAR;
    PG8_STAGE(PG8_SB(1, 0), cB + kstep, voffB); PG8_STAGE(PG8_SA(1, 0), cA + kstep, voffA); PG8_STAGE(PG8_SB(1, 1), cB + hstepB + kstep, voffB);
    PG8_WAIT_V(6); PG8_BAR;
    for (;;) {
        const bool has_next = S.next(ui + 1, nxt);
        const char* nA = cA; const char* nB = cB; if (has_next) J.ptrs(g, nxt, nA, nB);
        for (int t = 0; t < nt; t += 2) {
            const bool last = (t == nt - 2);
            const char* a1 = cA + (size_t)(t + 1) * kstep;
            const char* a2 = last ? nA : cA + (size_t)(t + 2) * kstep; const char* b2 = last ? nB : cB + (size_t)(t + 2) * kstep;
            const char* a3 = a2 + kstep; const char* b3 = b2 + kstep;
            PG8_LDB(B0, 0, 0); PG8_LDB(B1, 0, 1); PG8_SCHED; PG8_LDA(At, 0, 0); PG8_STAGE(PG8_SA(1, 1), a1 + hstepA, voffA);
            PG8_WAIT_V(8); PG8_WAIT_L(0); PG8_BAR; PG8_MMA(0, 0, At, B0); PG8_MMA(0, 1, At, B1); PG8_BAR; PG8_SCHED;
            PG8_LDA(At, 0, 1); PG8_STAGE(PG8_SB(0, 0), b2, voffB); PG8_STAGE(PG8_SB(0, 1), b2 + hstepB, voffB); PG8_STAGE(PG8_SA(0, 0), a2, voffA);
            PG8_WAIT_V(8); PG8_WAIT_L(0); PG8_BAR; PG8_MMA(1, 0, At, B0); PG8_MMA(1, 1, At, B1); PG8_BAR; PG8_SCHED;
            PG8_LDB(B0, 1, 0); PG8_LDB(B1, 1, 1); PG8_SCHED; PG8_LDA(At, 1, 0); PG8_STAGE(PG8_SA(0, 1), a2 + hstepA, voffA);
            PG8_WAIT_V(8); PG8_WAIT_L(0); PG8_BAR; PG8_MMA(0, 0, At, B0); PG8_MMA(0, 1, At, B1); PG8_BAR; PG8_SCHED;
            PG8_LDA(At, 1, 1); PG8_STAGE(PG8_SB(1, 0), b3, voffB); PG8_STAGE(PG8_SB(1, 1), b3 + hstepB, voffB); PG8_STAGE(PG8_SA(1, 0), a3, voffA);
            PG8_WAIT_V(8); PG8_WAIT_L(0); PG8_BAR; PG8_MMA(1, 0, At, B0); PG8_MMA(1, 1, At, B1); PG8_BAR; PG8_SCHED;
        }
        if (wr == 0) PG8_BAR;
        { int t2 = threadIdx.x; asm volatile("" : "+v"(t2));
          const int w2 = __builtin_amdgcn_readfirstlane(t2 >> 6), l2 = t2 & 63; J.epi(acc, cur, w2 >> 2, w2 & 3, l2 & 15, l2 >> 4); }
        if (!has_next) break;
#pragma unroll
        for (int a = 0; a < 2; ++a)
#pragma unroll
            for (int b = 0; b < 2; ++b)
#pragma unroll
                for (int m = 0; m < 4; ++m)
#pragma unroll
                    for (int n = 0; n < 2; ++n) acc[a][b][m][n] = (f32x4){0.f, 0.f, 0.f, 0.f};
        cur = nxt; cA = nA; cB = nB; ++ui;
        if (wr == 1) PG8_BAR;
    }
    PG8_WAIT_V(0);
    PG8_BAR;
#undef PG8_SA
#undef PG8_SB
#undef PG8_STAGE
#undef PG8_LDA
#undef PG8_LDB
#undef PG8_MMA
#undef PG8_WAIT_V
#undef PG8_WAIT_L
#undef PG8_BAR
#undef PG8_SCHED
}

__device__ __forceinline__ void epi_store_bf16(const Acc& acc, bf16_t* O, int ldc, int row0, int col0, const float* cbias  , float scale) {
    f32x4 bv[2][2];
#pragma unroll
    for (int bj = 0; bj < 2; ++bj)
#pragma unroll
        for (int n = 0; n < 2; ++n) bv[bj][n] = cbias ? *(const f32x4*)(cbias + bj * HALF + 4 * n) : (f32x4){0.f, 0.f, 0.f, 0.f};
#pragma unroll
    for (int ai = 0; ai < 2; ++ai)
#pragma unroll
        for (int m = 0; m < 4; ++m) { bf16_t* rowp = O + (size_t)(row0 + ai * HALF + m * 16) * ldc + col0;
#pragma unroll
            for (int bj = 0; bj < 2; ++bj) st_bf8(rowp + bj * HALF, (acc[ai][bj][m][0] + bv[bj][0]) * scale, (acc[ai][bj][m][1] + bv[bj][1]) * scale); }
}
__device__ __forceinline__ void epi_swiglu(const Acc& acc, bf16_t* H, int row0, int hcol0) {
#pragma unroll
    for (int ai = 0; ai < 2; ++ai)
#pragma unroll
        for (int m = 0; m < 4; ++m) { bf16_t* rowp = H + (size_t)(row0 + ai * HALF + m * 16) * FF_ + hcol0;
            f32x4 h[2];
#pragma unroll
            for (int n = 0; n < 2; ++n)
#pragma unroll
                for (int i = 0; i < 4; ++i) { const float gt = acc[ai][0][m][n][i], up = acc[ai][1][m][n][i]; h[n][i] = gt * fast_sigmoid(gt) * up; }
            st_bf8(rowp, h[0], h[1]); }
}

typedef volatile LAS unsigned long long* PTab;
__device__ __forceinline__ void std_ptrs(const Gemm& g, const Unit& u, const char*& a, const char*& b) {
    a = (const char*)g.A + (size_t)u.pm * BM * g.lda * 2; b = (const char*)g.Bt + (size_t)u.pn * BM * g.K * 2; }
struct JobStd {
    PTab ptab; unsigned o_off; int bias_idx; float scale;
    __device__ __forceinline__ void ptrs(const Gemm& g, const Unit& u, const char*& a, const char*& b) const { std_ptrs(g, u, a, b); }
    __device__ __forceinline__ void epi(const Acc& acc, const Unit& u, int wr, int wc, int fr, int fq) const {
        const int col0 = u.pn * BM + wc * 32 + 8 * fq;
        epi_store_bf16(acc, (bf16_t*)(WSP() + o_off), 1024, u.pm * BM + wr * 64 + fr, col0, bias_idx >= 0 ? INP(bias_idx) + col0 : nullptr, scale); }
};
struct JobSwi {
    PTab ptab;
    __device__ __forceinline__ void ptrs(const Gemm& g, const Unit& u, const char*& a, const char*& b) const { std_ptrs(g, u, a, b); }
    __device__ __forceinline__ void epi(const Acc& acc, const Unit& u, int wr, int wc, int fr, int fq) const {
        epi_swiglu(acc, (bf16_t*)(WSP() + WS_HID), u.pm * BM + wr * 64 + fr, 128 * u.pn + wc * 32 + 8 * fq); }
};
struct JobG3 {
    PTab ptab; int rowbase;
    __device__ __forceinline__ void ptrs(const Gemm& g, const Unit& u, const char*& a, const char*& b) const {
        const int blk = u.pn < 12 ? (u.pn >> 2) : (u.pn - 9);
        a = (const char*)g.A + (size_t)u.pm * BM * g.lda * 2 + (size_t)blk * 2048; b = (const char*)g.Bt + (size_t)u.pn * BM * g.K * 2; }
    __device__ __forceinline__ void epi(const Acc& acc, const Unit& u, int wr, int wc, int fr, int fq) const {
        const int row0 = rowbase + u.pm * BM + wr * 64 + fr;
        if (u.pn < 12) { epi_store_bf16(acc, (bf16_t*)(WSP() + WS_RKV), 3072, row0, u.pn * BM + wc * 32 + 8 * fq, nullptr, 1.0f); return; }
        const int kind = u.pn - 12;
        if (kind < 2 && wc >= 2) return;
        bf16_t* LD = (bf16_t*)(WSP() + WS_LD);
        const int dcol = (kind == 0 ? 0 : (kind == 1 ? 64 : 128)) + wc * 32 + 8 * fq;
#pragma unroll
        for (int ai = 0; ai < 2; ++ai)
#pragma unroll
            for (int m = 0; m < 4; ++m) { f32x4 v[2];
#pragma unroll
                for (int n = 0; n < 2; ++n)
#pragma unroll
                    for (int i = 0; i < 4; ++i) { const float x = acc[ai][0][m][n][i]; v[n][i] = kind == 0 ? fast_tanh(x) : (kind == 1 ? x : fast_sigmoid(x)); }
                st_bf8(LD + (size_t)(row0 + ai * HALF + m * 16) * 256 + dcol, v[0], v[1]); }
    }
};
struct JobG4 {
    PTab ptab;
    __device__ __forceinline__ void ptrs(const Gemm& g, const Unit& u, const char*& a, const char*& b) const { std_ptrs(g, u, a, b); }
    __device__ __forceinline__ void epi(const Acc& acc, const Unit& u, int wr, int wc, int fr, int fq) const {
        const int kind = u.pn >> 2, row0 = u.pm * BM + wr * 64 + fr, col0 = (u.pn & 3) * BM + wc * 32 + 8 * fq;
        unsigned char* ws = WSP();
        if (kind == 2) { epi_store_bf16(acc, (bf16_t*)(ws + WS_G), 1024, row0, col0, nullptr, 1.0f); return; }
        const float* bsrc = kind == 0 ? INP(I_W0) : INP(I_A0); bf16_t* O = (bf16_t*)(ws + (kind == 0 ? WS_DEC : WS_A));
        f32x4 bv[2][2];
#pragma unroll
        for (int bj = 0; bj < 2; ++bj)
#pragma unroll
            for (int n = 0; n < 2; ++n) bv[bj][n] = *(const f32x4*)(bsrc + col0 + bj * HALF + 4 * n);
#pragma unroll
        for (int ai = 0; ai < 2; ++ai)
#pragma unroll
            for (int m = 0; m < 4; ++m)
#pragma unroll
                for (int bj = 0; bj < 2; ++bj) { f32x4 v[2];
#pragma unroll
                    for (int n = 0; n < 2; ++n)
#pragma unroll
                        for (int i = 0; i < 4; ++i) { const float z = acc[ai][bj][m][n][i] + bv[bj][n][i];
                            if (kind == 0) { const float x = -z; const float sp = fmaxf(x, 0.f) + __logf(1.0f + fast_exp(-fabsf(x))); v[n][i] = -fast_exp(-sp - 0.5f); }
                            else v[n][i] = fast_sigmoid(z); }
                    st_bf8(O + (size_t)(row0 + ai * HALF + m * 16) * 1024 + col0 + bj * HALF, v[0], v[1]); }
    }
};
struct JobG8 {
    PTab ptab;
    __device__ __forceinline__ void ptrs(const Gemm& g, const Unit& u, const char*& a, const char*& b) const {
        const char* xa = (const char*)g.A + (size_t)u.pm * BM * g.lda * 2; const char* ws = (const char*)WSP();
        if (u.pn == 1) { a = ws + WS_WKV + (size_t)256 * 1024 * 2; b = xa; }
        else { a = xa; b = u.pn == 0 ? ws + WS_WKV : ws + WS_WIN + 2 * WIN_STRIDE + (size_t)(u.pn - 2) * BM * g.K * 2; } }
    __device__ __forceinline__ void epi(const Acc& acc, const Unit& u, int wr, int wc, int fr, int fq) const {
        const int row0 = u.pm * BM + wr * 64 + fr; unsigned char* ws = WSP();
        if (u.pn >= 2) { epi_swiglu(acc, (bf16_t*)(ws + WS_HID), row0, 128 * (u.pn - 2) + wc * 32 + 8 * fq); return; }
        const float* bkv = INP(I_BKV);
        if (u.pn == 0) { const int col0 = wc * 32 + 8 * fq; epi_store_bf16(acc, (bf16_t*)(ws + WS_KB), 256, row0, col0, bkv + col0, 1.0f); return; }
        bf16_t* VT = (bf16_t*)(ws + WS_VT);
        const int r0 = wr * 64 + fr, c0 = u.pm * BM + wc * 32 + 8 * fq;
#pragma unroll
        for (int ai = 0; ai < 2; ++ai)
#pragma unroll
            for (int m = 0; m < 4; ++m) { const int r = r0 + ai * HALF + m * 16; const float bb = bkv[256 + r];
#pragma unroll
                for (int bj = 0; bj < 2; ++bj) st_bf8(VT + (size_t)r * M_ + c0 + bj * HALF, acc[ai][bj][m][0] + bb, acc[ai][bj][m][1] + bb); }
    }
};
}

struct Args { const float* in[28]; float* out; unsigned char* ws; int stop; int pad; };

__device__ __forceinline__ void tr_item(const float* W, int N, int k0, int n0, bf16_t* dst  , int ldk, const float* gain, LAS float* scr, int lane) {
#pragma unroll 8
    for (int i = 0; i < 32; ++i) { const int kk = 2 * i + (lane >> 5); float v = W[(size_t)(k0 + kk) * N + n0 + (lane & 31)]; if (gain) v *= gain[k0 + kk]; scr[kk * 33 + (lane & 31)] = v; }
    asm volatile("s_waitcnt lgkmcnt(0)" ::: "memory");
    const int c = lane & 7;
#pragma unroll
    for (int j = 0; j < 4; ++j) { const int n = (lane >> 3) + 8 * j; const LAS float* s = scr + (8 * c) * 33 + n;
        u32x4 o; o.x = cvt_pk_bf16(s[0 * 33], s[1 * 33]); o.y = cvt_pk_bf16(s[2 * 33], s[3 * 33]); o.z = cvt_pk_bf16(s[4 * 33], s[5 * 33]); o.w = cvt_pk_bf16(s[6 * 33], s[7 * 33]);
        *(u32x4*)(dst + (size_t)n * ldk + 8 * c) = o; }
    asm volatile("s_waitcnt lgkmcnt(0)" ::: "memory");
}

__device__ __forceinline__ float sumsq4(const f32x4 (&v)[4]) { float s = 0.f;
#pragma unroll
    for (int j = 0; j < 4; ++j) s += (v[j][0] * v[j][0] + v[j][1] * v[j][1]) + (v[j][2] * v[j][2] + v[j][3] * v[j][3]);
    return s; }

__device__ __forceinline__ void run_phase(const int ph, volatile LAS unsigned long long* ptab0, LAS unsigned char* lds) {
    {
        int tid = threadIdx.x; asm volatile("" : "+v"(tid));
        volatile LAS unsigned long long* ptab = ptab0; asm volatile("" : "+s"(ptab));
        int G = gridDim.x, bx = blockIdx.x; asm volatile("" : "+s"(G), "+s"(bx));
        const int lane = tid & 63, wave = __builtin_amdgcn_readfirstlane(tid >> 6);
        const int vcu = (G % 8 == 0) ? (bx % 8) * (G / 8) + bx / 8 : bx;
        const int gw = vcu * NWAVES + wave, NGW = G * NWAVES;
        unsigned char* ws = (unsigned char*)ldp(ptab, 29);
        float* HA = (float*)ldp(ptab, 28);
        const float* normg = INP(I_NORMG);
        bf16_t* F = (bf16_t*)(ws + WS_F); bf16_t* XN = (bf16_t*)(ws + WS_XN); bf16_t* HID = (bf16_t*)(ws + WS_HID);
        if (ph == 0) {
            LAS float* scr = (LAS float*)(lds + wave * 16384);
            constexpr int NITEMS = 20480;
            for (int it = gw; it < NITEMS; it += NGW) {
                int r = it; const float* W; int N; bf16_t* dst; int ldk; const float* gain = nullptr; int mode = 0;
                if (r < 11264) { const int f = r / 2816; r -= f * 2816; W = INP(I_WIN) + (size_t)f * 1024 * 5632; N = 5632; dst = (bf16_t*)(ws + WS_WIN + f * WIN_STRIDE); ldk = 1024; mode = 1;
                    gain = normg + ((f >> 1) * 6 + ((f & 1) ? 4 : 0)) * 1024; }
                else if ((r -= 11264) < 5632) { const int f = r / 1408; r -= f * 1408; W = INP(I_WOUT) + (size_t)f * 2816 * 1024; N = 1024; dst = (bf16_t*)(ws + WS_WOUT + f * WOUT_STRIDE); ldk = 2816; }
                else if ((r -= 5632) < 1536) { const int c = r / 512; r -= c * 512; W = INP(I_WRKV) + (size_t)c * 1024 * 1024; N = 1024; dst = (bf16_t*)(ws + WS_B3) + (size_t)c * 1024 * 1024; ldk = 1024; }
                else if ((r -= 1536) < 32) { W = INP(I_W1); N = 64; dst = (bf16_t*)(ws + WS_B3) + (size_t)3072 * 1024; ldk = 1024; }
                else if ((r -= 32) < 32) { W = INP(I_A1); N = 64; dst = (bf16_t*)(ws + WS_B3) + (size_t)3328 * 1024; ldk = 1024; }
                else if ((r -= 32) < 64) { W = INP(I_G1); N = 128; dst = (bf16_t*)(ws + WS_B3) + (size_t)3584 * 1024; ldk = 1024; }
                else if ((r -= 64) < 32) { W = INP(I_W2); N = 1024; dst = (bf16_t*)(ws + WS_LUP); ldk = 256; }
                else if ((r -= 32) < 32) { W = INP(I_A2); N = 1024; dst = (bf16_t*)(ws + WS_LUP) + (size_t)1024 * 256 + 64; ldk = 256; }
                else if ((r -= 32) < 64) { W = INP(I_G2); N = 1024; dst = (bf16_t*)(ws + WS_LUP) + (size_t)2048 * 256 + 128; ldk = 256; }
                else if ((r -= 64) < 512) { W = INP(I_RWO); N = 1024; dst = (bf16_t*)(ws + WS_RWO); ldk = 1024; }
                else if ((r -= 512) < 256) { W = INP(I_WKV); N = 512; dst = (bf16_t*)(ws + WS_WKV); ldk = 1024; gain = INP(I_KVG); }
                else if ((r -= 256) < 512) { W = INP(I_WQ); N = 1024; dst = (bf16_t*)(ws + WS_WQ); ldk = 1024; gain = normg + (6 + 2) * 1024; }
                else { r -= 512; W = INP(I_AWO); N = 1024; dst = (bf16_t*)(ws + WS_AWO); ldk = 1024; }
                const int nblk = N / 32, kb = r / nblk, nb = r % nblk, k0 = 64 * kb, n0 = 32 * nb;
                int drow = n0;
                if (mode == 1) drow = n0 < FF_ ? (n0 >> 7) * 256 + (n0 & 127) : ((n0 - FF_) >> 7) * 256 + 128 + ((n0 - FF_) & 127);
                tr_item(W, N, k0, n0, dst + (size_t)drow * ldk + k0, ldk, gain, scr, lane);
            }
            const float* x = INP(I_X);
            for (int row = gw; row < M_; row += NGW) {
                f32x4 v[4];
#pragma unroll
                for (int j = 0; j < 4; ++j) v[j] = *(const f32x4*)(x + (size_t)row * D_ + 4 * lane + 256 * j);
                const float rs = rsqrtf(wave_sum(sumsq4(v)) * (1.0f / D_) + RMS_EPS);
#pragma unroll
                for (int j = 0; j < 4; ++j) st_bf4(XN + (size_t)row * D_ + 4 * lane + 256 * j, v[j] * rs);
            }
        }
        else if (ph == 1 || ph == 12 || ph == 22) {
            const int f = ph == 1 ? 0 : (ph == 12 ? 1 : 3);
            pg8::Gemm g{XN, (const bf16_t*)(ws + WS_WIN + f * WIN_STRIDE), M_, 2 * FF_, D_, D_};
            pg8::StaticOrder S; S.init(M_, 2 * FF_, G, bx);
            pg8::JobSwi J{ptab};
            pg8::gemm_phase<pg8::JobSwi>(lds, g, S, J);
        }
        else if (ph == 2 || ph == 13 || ph == 16 || ph == 23 || ph == 10 || ph == 18 || ph == 20) {
            pg8::Gemm g; pg8::JobStd J;
            if (ph == 10) { g = pg8::Gemm{(const bf16_t*)(ws + WS_YG), (const bf16_t*)(ws + WS_RWO), M_, D_, D_, D_}; J = pg8::JobStd{ptab, (unsigned)WS_F, -1, 1.0f}; }
            else if (ph == 18) { g = pg8::Gemm{XN, (const bf16_t*)(ws + WS_WQ), M_, D_, D_, D_}; J = pg8::JobStd{ptab, (unsigned)WS_Q, I_BQ, QSCALE}; }
            else if (ph == 20) { g = pg8::Gemm{(const bf16_t*)(ws + WS_O), (const bf16_t*)(ws + WS_AWO), M_, D_, D_, D_}; J = pg8::JobStd{ptab, (unsigned)WS_F, I_BO, 1.0f}; }
            else { const int f = ph == 2 ? 0 : (ph == 13 ? 1 : (ph == 16 ? 2 : 3));
                g = pg8::Gemm{HID, (const bf16_t*)(ws + WS_WOUT + f * WOUT_STRIDE), M_, D_, FF_, FF_}; J = pg8::JobStd{ptab, (unsigned)WS_F, -1, 1.0f}; }
            pg8::StaticOrder S; S.init(M_, D_, G, bx);
            pg8::gemm_phase<pg8::JobStd>(lds, g, S, J);
        }
        else if (ph == 3 || ph == 5) {
            const int hb = ph == 3 ? 0 : 1;
            LAS float* mus = (LAS float*)lds;
            for (int e = tid; e < 6 * 1024; e += NTHR) { const int c = e >> 10; const int src = c == 0 ? 0 : (c == 1 ? 2 : (c == 2 ? 3 : (c == 3 ? 1 : c))); mus[e] = INP(I_MU)[src * 1024 + (e & 1023)]; }
            __syncthreads();
            const float* x = INP(I_X); bf16_t* X6 = (bf16_t*)(ws + WS_X6);
            f32x4 g1[4], g2[4];
#pragma unroll
            for (int j = 0; j < 4; ++j) { g1[j] = *(const f32x4*)(normg + 1 * 1024 + 4 * lane + 256 * j) * 0.5f; g2[j] = *(const f32x4*)(normg + 2 * 1024 + 4 * lane + 256 * j); }
            const int r0 = 8192 * hb + 4 * gw;
            f32x4 up[4];
#pragma unroll
            for (int j = 0; j < 4; ++j) up[j] = (f32x4){0.f, 0.f, 0.f, 0.f};
            for (int rr = ((r0 & (T_ - 1)) ? -1 : 0); rr < 4; ++rr) {
                const int row = r0 + rr;
                f32x4 fv[4], h[4];
#pragma unroll
                for (int j = 0; j < 4; ++j) { fv[j] = ld_bf4(F + (size_t)row * D_ + 4 * lane + 256 * j); h[j] = *(const f32x4*)(x + (size_t)row * D_ + 4 * lane + 256 * j); }
                const float rs1 = rsqrtf(wave_sum(sumsq4(fv)) * (1.0f / D_) + RMS_EPS);
#pragma unroll
                for (int j = 0; j < 4; ++j) h[j] = h[j] + fv[j] * rs1 * g1[j];
                const float rs2 = rsqrtf(wave_sum(sumsq4(h)) * (1.0f / D_) + RMS_EPS);
                if (rr >= 0) {
#pragma unroll
                    for (int j = 0; j < 4; ++j) *(f32x4*)(HA + (size_t)row * D_ + 4 * lane + 256 * j) = h[j];
                }
#pragma unroll
                for (int j = 0; j < 4; ++j) { const f32x4 u = h[j] * rs2 * g2[j];
                    if (rr >= 0) { const f32x4 xx = up[j] - u; bf16_t* dstp = X6 + (size_t)(row - 8192 * hb) * 6144 + 4 * lane + 256 * j;
#pragma unroll
                        for (int c = 0; c < 6; ++c) st_bf4(dstp + c * 1024, u + xx * *(const LAS f32x4*)(mus + c * 1024 + 4 * lane + 256 * j)); }
                    up[j] = u; }
            }
        }
        else if (ph == 4 || ph == 6) {
            const int hb = ph == 4 ? 0 : 1;
            pg8::Gemm g{(const bf16_t*)(ws + WS_X6), (const bf16_t*)(ws + WS_B3), 8192, 3840, D_, 6144};
            pg8::StaticOrder S; S.init(8192, 3840, G, bx);
            pg8::JobG3 J{ptab, 8192 * hb};
            pg8::gemm_phase<pg8::JobG3>(lds, g, S, J);
        }
        else if (ph == 7) {
            pg8::Gemm g{(const bf16_t*)(ws + WS_LD), (const bf16_t*)(ws + WS_LUP), M_, 3072, 256, 256};
            pg8::StaticOrder S; S.init(M_, 3072, G, bx);
            pg8::JobG4 J{ptab};
            pg8::gemm_phase<pg8::JobG4>(lds, g, S, J);
        }
        else if (ph == 8) {
            constexpr int TC = 32, NCH = T_ / TC;
            constexpr int BUFB = TC * 1280 + TC * 64 + TC * 64;
            const int bh = vcu >> 2, rq = vcu & 3, bb = bh >> 4, hh = bh & 15;
            const bf16_t* RKV = (const bf16_t*)(ws + WS_RKV); const bf16_t* DEC = (const bf16_t*)(ws + WS_DEC); const bf16_t* Aa = (const bf16_t*)(ws + WS_A);
            float* Y = (float*)(ws + WS_Y);
            const size_t rowbase = (size_t)bb * T_;
            if (vcu < 256) {
            if (wave < 4) {
                const int ri = lane >> 4, j4 = lane & 15;
                float S0 = 0.f, S1 = 0.f, S2 = 0.f, S3 = 0.f;
                __syncthreads();
                for (int ci = 0; ci < NCH; ++ci) {
                    const LAS unsigned char* buf = lds + (ci & 1) * BUFB;
                    const LAS float* vb = (const LAS float*)(buf + TC * 1280) + wave * 4 + ri;
                    LAS float* yb = (LAS float*)(buf + TC * 1280 + TC * 64) + wave * 4 + ri;
#pragma unroll 8
                    for (int s = 0; s < TC; ++s) {
                        const LAS unsigned char* p = buf + s * 1280 + j4 * 16;
                        const f32x4 nk = *(const LAS f32x4*)(p), w = *(const LAS f32x4*)(p + 256), b = *(const LAS f32x4*)(p + 512), k = *(const LAS f32x4*)(p + 768), r = *(const LAS f32x4*)(p + 1024);
                        const float v = vb[s * 16];
                        float sa = (S0 * nk[0] + S1 * nk[1]) + (S2 * nk[2] + S3 * nk[3]);
                        sa = rowsum16(sa);
                        S0 = S0 * w[0] + (sa * b[0] + v * k[0]); S1 = S1 * w[1] + (sa * b[1] + v * k[1]);
                        S2 = S2 * w[2] + (sa * b[2] + v * k[2]); S3 = S3 * w[3] + (sa * b[3] + v * k[3]);
                        float y = (S0 * r[0] + S1 * r[1]) + (S2 * r[2] + S3 * r[3]);
                        y = rowsum16(y);
                        if (j4 == 0) yb[s * 16] = y;
                    }
                    __syncthreads();
                }
            } else {
                const int lw = wave - 4, ss = lane >> 4, j4 = lane & 15;
                const f32x4 kk4 = *(const f32x4*)(INP(I_KK) + hh * 64 + 4 * j4), ka4 = *(const f32x4*)(INP(I_KA) + hh * 64 + 4 * j4);
                const int e = lw * 128 + lane * 2, es = e >> 4, ei = e & 15;
                for (int ci = -1; ci < NCH; ++ci) {
                    if (ci > 0) {
                        const LAS unsigned char* buf = lds + ((ci - 1) & 1) * BUFB;
                        const f32x2 yv = *(const LAS f32x2*)(buf + TC * 1280 + TC * 64 + (es * 16 + ei) * 4);
                        *(f32x2*)(Y + (rowbase + (size_t)(ci - 1) * TC + es) * D_ + hh * 64 + rq * 16 + ei) = yv;
                    }
                    if (ci + 1 < NCH) {
                        LAS unsigned char* buf = lds + ((ci + 1) & 1) * BUFB;
                        const size_t t0 = rowbase + (size_t)(ci + 1) * TC;
#pragma unroll
                        for (int it = 0; it < 2; ++it) {
                            const int s = lw * 8 + it * 4 + ss; const size_t row = t0 + s;
                            const f32x4 r4 = ld_bf4(RKV + row * 3072 + hh * 64 + 4 * j4), k4 = ld_bf4(RKV + row * 3072 + 1024 + hh * 64 + 4 * j4);
                            const f32x4 a4 = ld_bf4(Aa + row * D_ + hh * 64 + 4 * j4), d4 = ld_bf4(DEC + row * D_ + hh * 64 + 4 * j4);
                            const f32x4 kk = k4 * kk4;
                            float q = (kk[0] * kk[0] + kk[1] * kk[1]) + (kk[2] * kk[2] + kk[3] * kk[3]);
                            q = rowsum16(q);
                            const float inv = 1.0f / fmaxf(sqrtf(q), 1e-12f);
                            const f32x4 kn = kk * inv;
                            f32x4 wv; wv[0] = fast_exp(d4[0]); wv[1] = fast_exp(d4[1]); wv[2] = fast_exp(d4[2]); wv[3] = fast_exp(d4[3]);
                            LAS unsigned char* p = buf + s * 1280 + j4 * 16;
                            *(LAS f32x4*)(p) = -kn; *(LAS f32x4*)(p + 256) = wv; *(LAS f32x4*)(p + 512) = kn * a4;
                            *(LAS f32x4*)(p + 768) = k4 * (1.0f + (a4 - 1.0f) * ka4); *(LAS f32x4*)(p + 1024) = r4;
                        }
                        const unsigned vv = *(const unsigned*)(RKV + (t0 + es) * 3072 + 2048 + hh * 64 + rq * 16 + ei);
                        *(LAS f32x2*)(buf + TC * 1280 + (es * 16 + ei) * 4) = (f32x2){bf_lo(vv), bf_hi(vv)};
                    }
                    __syncthreads();
                }
                {
                    const LAS unsigned char* buf = lds + ((NCH - 1) & 1) * BUFB;
                    const f32x2 yv = *(const LAS f32x2*)(buf + TC * 1280 + TC * 64 + (es * 16 + ei) * 4);
                    *(f32x2*)(Y + (rowbase + (size_t)(NCH - 1) * TC + es) * D_ + hh * 64 + rq * 16 + ei) = yv;
                }
            }
            }
        }
        else if (ph == 9) {
            const bf16_t* RKV = (const bf16_t*)(ws + WS_RKV); const bf16_t* Aa = (const bf16_t*)(ws + WS_A); const bf16_t* Gg = (const bf16_t*)(ws + WS_G);
            const float* Y = (const float*)(ws + WS_Y); bf16_t* YG = (bf16_t*)(ws + WS_YG);
            for (int row = gw; row < M_; row += NGW) {
#pragma unroll
                for (int j = 0; j < 4; ++j) {
                    const int col = 4 * lane + 256 * j;
                    const f32x4 y = *(const f32x4*)(Y + (size_t)row * D_ + col);
                    const f32x4 r4 = ld_bf4(RKV + (size_t)row * 3072 + col), k4 = ld_bf4(RKV + (size_t)row * 3072 + 1024 + col), v4 = ld_bf4(RKV + (size_t)row * 3072 + 2048 + col);
                    const f32x4 a4 = ld_bf4(Aa + (size_t)row * D_ + col), g4 = ld_bf4(Gg + (size_t)row * D_ + col);
                    const f32x4 ka = *(const f32x4*)(INP(I_KA) + col), rk = *(const f32x4*)(INP(I_RK) + col);
                    const f32x4 gg = *(const f32x4*)(INP(I_GNG) + col), gb = *(const f32x4*)(INP(I_GNB) + col);
                    const float mean = rowsum16((y[0] + y[1]) + (y[2] + y[3])) * (1.0f / 64.0f);
                    const f32x4 dy = y - mean;
                    const float var = rowsum16((dy[0] * dy[0] + dy[1] * dy[1]) + (dy[2] * dy[2] + dy[3] * dy[3])) * (1.0f / 64.0f);
                    const float rstd = rsqrtf(var + GN_EPS);
                    const f32x4 kp = k4 * (1.0f + (a4 - 1.0f) * ka);
                    const f32x4 t = r4 * kp * rk;
                    const float bon = rowsum16((t[0] + t[1]) + (t[2] + t[3]));
                    st_bf4(YG + (size_t)row * D_ + col, (dy * rstd * gg + gb + v4 * bon) * g4);
                }
            }
        }
        else if (ph == 11 || ph == 14 || ph == 17 || ph == 21 || ph == 24) {
            const int gi = ph == 11 ? 3 : (ph == 14 ? 5 : (ph == 17 ? 7 : (ph == 21 ? 9 : 11)));
            const float c = (ph == 11 || ph == 21) ? 1.0f : 0.5f;
            const bool want_xn = ph != 24;
            f32x4 ga[4];
#pragma unroll
            for (int j = 0; j < 4; ++j) ga[j] = *(const f32x4*)(normg + gi * 1024 + 4 * lane + 256 * j) * c;
            for (int row = gw; row < M_; row += NGW) {
                f32x4 fv[4], h[4];
#pragma unroll
                for (int j = 0; j < 4; ++j) { fv[j] = ld_bf4(F + (size_t)row * D_ + 4 * lane + 256 * j); h[j] = *(const f32x4*)(HA + (size_t)row * D_ + 4 * lane + 256 * j); }
                const float rs1 = rsqrtf(wave_sum(sumsq4(fv)) * (1.0f / D_) + RMS_EPS);
#pragma unroll
                for (int j = 0; j < 4; ++j) { h[j] = h[j] + fv[j] * rs1 * ga[j]; *(f32x4*)(HA + (size_t)row * D_ + 4 * lane + 256 * j) = h[j]; }
                if (want_xn) {
                    const float rs2 = rsqrtf(wave_sum(sumsq4(h)) * (1.0f / D_) + RMS_EPS);
#pragma unroll
                    for (int j = 0; j < 4; ++j) st_bf4(XN + (size_t)row * D_ + 4 * lane + 256 * j, h[j] * rs2);
                }
            }
        }
        else if (ph == 15) {
            pg8::Gemm g{XN, nullptr, M_, 2 * FF_ + 512, D_, D_};
            pg8::StaticOrder S; S.init(M_, 2 * FF_ + 512, G, bx);
            pg8::JobG8 J{ptab};
            pg8::gemm_phase<pg8::JobG8>(lds, g, S, J);
        }
        else if (ph == 19) {
            const bf16_t* Q = (const bf16_t*)(ws + WS_Q); const bf16_t* KB = (const bf16_t*)(ws + WS_KB); const bf16_t* VT = (const bf16_t*)(ws + WS_VT); bf16_t* O = (bf16_t*)(ws + WS_O);
            LAS bf16_t* Ks = (LAS bf16_t*)lds;
            LAS bf16_t* Vs = (LAS bf16_t*)(lds + 36864);
            const int fr = lane & 15, fq = lane >> 4;
            for (int unit = vcu; unit < 512; unit += G) {
                const int nb = unit & 31, kvh = (unit >> 5) & 3, bb = unit >> 7;
                const size_t rowbase = (size_t)bb * T_; const int t0 = 128 * (nb - 1);
                __syncthreads();
#pragma unroll
                for (int i = 0; i < 4; ++i) { const int c = tid + NTHR * i; const int key = c >> 3, part = c & 7;
                    u32x4 v = (u32x4){0u, 0u, 0u, 0u};
                    if (nb > 0 || key >= 128) v = *(const u32x4*)(KB + (rowbase + t0 + key) * 256 + kvh * 64 + part * 8);
                    *(LAS u32x4*)(Ks + key * 72 + part * 8) = v; }
#pragma unroll
                for (int i = 0; i < 4; ++i) { const int c = tid + NTHR * i; const int d = c >> 5, part = c & 31;
                    u32x4 v = (u32x4){0u, 0u, 0u, 0u};
                    if (nb > 0 || part >= 16) v = *(const u32x4*)(VT + (size_t)(kvh * 64 + d) * M_ + rowbase + t0 + part * 8);
                    *(LAS u32x4*)(Vs + d * 264 + part * 8) = v; }
                __syncthreads();
                const int gi = wave >> 1, qh = wave & 1, hq = kvh * 4 + gi;
                const float sink = INP(I_SINK)[hq] * LOG2E;
                for (int qt = 0; qt < 4; ++qt) {
                    const int qo = 64 * qh + 16 * qt, kt0 = qo >> 4;
                    const size_t qrow = rowbase + 128 * nb + qo + fr;
                    bf16x8 bq[2];
#pragma unroll
                    for (int ks = 0; ks < 2; ++ks) bq[ks] = *(const bf16x8*)(Q + qrow * D_ + hq * 64 + 32 * ks + 8 * fq);
                    f32x4 sc[9];
#pragma unroll
                    for (int i = 0; i < 9; ++i) { sc[i] = (f32x4){0.f, 0.f, 0.f, 0.f};
#pragma unroll
                        for (int ks = 0; ks < 2; ++ks) { const bf16x8 ka = *(const LAS bf16x8*)(Ks + (16 * (kt0 + i) + fr) * 72 + 32 * ks + 8 * fq);
                            sc[i] = __builtin_amdgcn_mfma_f32_16x16x32_bf16(ka, bq[ks], sc[i], 0, 0, 0); } }
                    const int qw = 128 + qo + fr;
                    float mx = sink;
#pragma unroll
                    for (int i = 0; i < 9; ++i)
#pragma unroll
                        for (int r = 0; r < 4; ++r) { const int kw = 16 * (kt0 + i) + 4 * fq + r; const bool ok = (kw <= qw) && (qw - kw < 128) && (nb > 0 || kw >= 128);
                            sc[i][r] = ok ? sc[i][r] : -1e30f; mx = fmaxf(mx, sc[i][r]); }
                    mx = fmaxf(mx, xlane(mx, lane ^ 16)); mx = fmaxf(mx, xlane(mx, lane ^ 32));
                    float ls = 0.f; bf16x4 pb[9];
#pragma unroll
                    for (int i = 0; i < 9; ++i) { f32x4 p;
#pragma unroll
                        for (int r = 0; r < 4; ++r) { p[r] = __builtin_amdgcn_exp2f(sc[i][r] - mx); ls += p[r]; }
                        u32x2 w; w.x = cvt_pk_bf16(p[0], p[1]); w.y = cvt_pk_bf16(p[2], p[3]); pb[i] = __builtin_bit_cast(bf16x4, w); }
                    ls += xlane(ls, lane ^ 16); ls += xlane(ls, lane ^ 32);
                    ls += __builtin_amdgcn_exp2f(sink - mx);
                    const float inv = 1.0f / ls;
#pragma unroll
                    for (int dt = 0; dt < 4; ++dt) { f32x4 o = (f32x4){0.f, 0.f, 0.f, 0.f};
#pragma unroll
                        for (int i = 0; i < 9; ++i) { const bf16x4 va = *(const LAS bf16x4*)(Vs + (16 * dt + fr) * 264 + 16 * (kt0 + i) + 4 * fq);
                            o = __builtin_amdgcn_mfma_f32_16x16x16bf16_1k(va, pb[i], o, 0, 0, 0); }
                        st_bf4(O + qrow * D_ + hq * 64 + 16 * dt + 4 * fq, o * inv); }
                }
            }
        }
    }
}
__global__ void __launch_bounds__(NTHR, 2) fwd_kernel(Args args) {
    extern __shared__ __attribute__((aligned(16))) unsigned char lds_raw[];
    cg::grid_group grid = cg::this_grid();
    LAS unsigned char* lds = (LAS unsigned char*)lds_raw;
    const int tid0 = threadIdx.x;
    volatile LAS unsigned long long* ptab0 = (volatile LAS unsigned long long*)(lds + PTAB_OFF);
    { volatile LAS unsigned long long* ptab = ptab0;
    if (tid0 == 0) {
#pragma unroll
        for (int i = 0; i < 28; ++i) ptab[i] = (unsigned long long)args.in[i];
        ptab[28] = (unsigned long long)args.out; ptab[29] = (unsigned long long)args.ws; ptab[30] = (unsigned long long)args.stop;
    }
    __syncthreads(); }
    const int nph = (int)ldp(ptab0, 30);
#define RP(k) if (nph <= (k)) return; run_phase((k), ptab0, lds); if (nph > (k) + 1) grid.sync();
    RP(0) RP(1) RP(2) RP(3) RP(4) RP(5) RP(6) RP(7) RP(8) RP(9) RP(10) RP(11) RP(12) RP(13) RP(14) RP(15) RP(16) RP(17) RP(18) RP(19) RP(20) RP(21) RP(22) RP(23) RP(24)
#undef RP
}

extern "C" void kernel_launch(void* const* d_in, const int* in_sizes, int n_in, void* d_out, int out_size, void* d_ws, size_t ws_size, hipStream_t stream) {
    static int grid = 0;
    if (grid == 0) {
        if (n_in != 28 || out_size != M_ * D_ || ws_size < WS_END) { fprintf(stderr, "kernel_launch: unexpected problem (n_in %d out %d ws %zu)\n", n_in, out_size, ws_size); grid = -1; return; }
        int dev = 0, cus = 0, per_cu = 0;
        (void)hipGetDevice(&dev); (void)hipDeviceGetAttribute(&cus, hipDeviceAttributeMultiprocessorCount, dev);
        if (hipFuncSetAttribute((const void*)fwd_kernel, hipFuncAttributeMaxDynamicSharedMemorySize, LDS_BYTES) != hipSuccess) { fprintf(stderr, "kernel_launch: hipFuncSetAttribute failed\n"); grid = -1; return; }
        if (hipOccupancyMaxActiveBlocksPerMultiprocessor(&per_cu, (const void*)fwd_kernel, NTHR, LDS_BYTES) != hipSuccess || per_cu < 1) { fprintf(stderr, "kernel_launch: occupancy query says %d\n", per_cu); per_cu = 1; }
        (void)hipGetLastError();
        grid = cus * 1;
        if (grid > 256) grid = 256;
    }
    if (grid < 0) return;
    (void)hipMemsetAsync((char*)d_ws + WS_B3 + (size_t)3072 * 1024 * 2, 0, (size_t)768 * 1024 * 2, stream);
    (void)hipMemsetAsync((char*)d_ws + WS_LUP, 0, (size_t)3072 * 256 * 2, stream);
    Args a{};
    for (int i = 0; i < 28; ++i) a.in[i] = (const float*)d_in[i];
    a.out = (float*)d_out; a.ws = (unsigned char*)d_ws; a.stop = 25; a.pad = 0;
    void* kargs[] = {&a};
    hipError_t e = hipLaunchCooperativeKernel((const void*)fwd_kernel, dim3(grid), dim3(NTHR), kargs, LDS_BYTES, stream);
    if (e != hipSuccess) fprintf(stderr, "kernel_launch: cooperative launch failed: %s (grid %d)\n", hipGetErrorString(e), grid);
}
```

```cpp
#include <hip/hip_runtime.h>
#include <hip/hip_cooperative_groups.h>
#include <cstdio>
#include <cstdint>
namespace cg = cooperative_groups;

#define LAS __attribute__((address_space(3)))
typedef unsigned short bf16_t;
typedef short bf16x8 __attribute__((ext_vector_type(8)));
typedef short bf16x4 __attribute__((ext_vector_type(4)));
typedef float f32x4 __attribute__((ext_vector_type(4)));
typedef float f32x2 __attribute__((ext_vector_type(2)));
typedef unsigned u32x4 __attribute__((ext_vector_type(4)));
typedef unsigned u32x2 __attribute__((ext_vector_type(2)));

constexpr int T_ = 4096, D_ = 1024, M_ = 16384, FF_ = 2816;
constexpr float RMS_EPS = 1e-6f, GN_EPS = 64e-5f;
constexpr float LOG2E = 1.4426950408889634f;
constexpr float QSCALE = 0.125f * LOG2E;
constexpr int NWAVES = 8, NTHR = 512;
constexpr int LDS_BYTES = 135168;

constexpr size_t MiB = 1u << 20;
constexpr size_t WS_WIN = 1 * MiB;
constexpr size_t WIN_STRIDE = 11 * MiB;
constexpr size_t WS_WOUT = 45 * MiB;
constexpr size_t WOUT_STRIDE = 5 * MiB + MiB / 2;
constexpr size_t WS_B3 = 67 * MiB;
constexpr size_t WS_LUP = 74 * MiB + MiB / 2;
constexpr size_t WS_RWO = 76 * MiB;
constexpr size_t WS_WKV = 78 * MiB;
constexpr size_t WS_WQ = 79 * MiB;
constexpr size_t WS_AWO = 81 * MiB;
constexpr size_t WS_F = 84 * MiB;
constexpr size_t WS_XN = 116 * MiB;
constexpr size_t WS_HID = 148 * MiB;
constexpr size_t WS_KB = 236 * MiB;
constexpr size_t WS_VT = 244 * MiB;
constexpr size_t WS_Q = 252 * MiB;
constexpr size_t WS_O = 284 * MiB;
constexpr size_t WS_X6 = 148 * MiB;
constexpr size_t WS_RKV = 244 * MiB;
constexpr size_t WS_LD = 340 * MiB;
constexpr size_t WS_DEC = 148 * MiB;
constexpr size_t WS_A = 180 * MiB;
constexpr size_t WS_G = 212 * MiB;
constexpr size_t WS_Y = 84 * MiB;
constexpr size_t WS_YG = 148 * MiB;
constexpr size_t WS_END = 352 * MiB;

__device__ __forceinline__ unsigned cvt_pk_bf16(float lo, float hi) { unsigned r; asm volatile("v_cvt_pk_bf16_f32 %0, %1, %2" : "=v"(r) : "v"(lo), "v"(hi)); return r; }
__device__ __forceinline__ float bf_lo(unsigned w) { return __builtin_bit_cast(float, w << 16); }
__device__ __forceinline__ float bf_hi(unsigned w) { return __builtin_bit_cast(float, w & 0xffff0000u); }
__device__ __forceinline__ f32x4 ld_bf4(const bf16_t* p) { const u32x2 w = *(const u32x2*)p; return (f32x4){bf_lo(w.x), bf_hi(w.x), bf_lo(w.y), bf_hi(w.y)}; }
__device__ __forceinline__ void st_bf4(bf16_t* p, f32x4 v) { u32x2 w; w.x = cvt_pk_bf16(v[0], v[1]); w.y = cvt_pk_bf16(v[2], v[3]); *(u32x2*)p = w; }
__device__ __forceinline__ void st_bf8(bf16_t* p, f32x4 v0, f32x4 v1) { u32x4 w; w.x = cvt_pk_bf16(v0[0], v0[1]); w.y = cvt_pk_bf16(v0[2], v0[3]); w.z = cvt_pk_bf16(v1[0], v1[1]); w.w = cvt_pk_bf16(v1[2], v1[3]); *(u32x4*)p = w; }
#define DPP_ADD(x, ctrl) x += __builtin_bit_cast(float, __builtin_amdgcn_update_dpp(0, __builtin_bit_cast(int, x), ctrl, 0xF, 0xF, true))
__device__ __forceinline__ float rowsum16(float x) { DPP_ADD(x, 0xB1); DPP_ADD(x, 0x4E); DPP_ADD(x, 0x141); DPP_ADD(x, 0x140); return x; }
__device__ __forceinline__ float rdlane(float x, int l) { return __builtin_bit_cast(float, __builtin_amdgcn_readlane(__builtin_bit_cast(int, x), l)); }
__device__ __forceinline__ float wave_sum(float v) { v = rowsum16(v); return (rdlane(v, 0) + rdlane(v, 16)) + (rdlane(v, 32) + rdlane(v, 48)); }
__device__ __forceinline__ float xlane(float x, int srclane) { return __builtin_bit_cast(float, __builtin_amdgcn_ds_bpermute(srclane << 2, __builtin_bit_cast(int, x))); }
__device__ __forceinline__ float fast_exp(float x) { return __builtin_amdgcn_exp2f(x * LOG2E); }
__device__ __forceinline__ float fast_sigmoid(float x) { return __builtin_amdgcn_rcpf(1.0f + fast_exp(-x)); }
__device__ __forceinline__ float fast_tanh(float x) { return 1.0f - 2.0f * __builtin_amdgcn_rcpf(fast_exp(2.0f * x) + 1.0f); }

enum { I_X = 0, I_NORMG, I_WIN, I_WOUT, I_MU, I_WRKV, I_RWO, I_W0, I_W1, I_W2, I_A0, I_A1, I_A2, I_G1, I_G2, I_KK, I_KA, I_RK, I_GNG, I_GNB, I_KVG, I_WKV, I_BKV, I_WQ, I_BQ, I_AWO, I_BO, I_SINK };
constexpr int PTAB_OFF = 131072;
__device__ __forceinline__ unsigned long long ldp(volatile LAS unsigned long long* t, int i) {
    const unsigned long long v = t[i];
    const unsigned lo = __builtin_amdgcn_readfirstlane((unsigned)v), hi = __builtin_amdgcn_readfirstlane((unsigned)(v >> 32));
    return ((unsigned long long)hi << 32) | lo;
}
#define INP(i) ((const float*)ldp(ptab, (i)))
#define WSP() ((unsigned char*)ldp(ptab, 29))
namespace pg8 {
constexpr int BM = 256, BK = 64, HALF = 128, HTB = HALF * BK * 2, STAGE_BYTES = 8 * HTB, NXCD = 8, WGM = 8;
__host__ __device__ __forceinline__ int lds_byte(int r, int c) { const int st = (r >> 4) * 2 + (c >> 5), rr = r & 15, cc = c & 31, ob = rr * 64 + cc * 2; return st * 1024 + (ob ^ (((ob >> 9) & 1) << 5)); }
__host__ __device__ __forceinline__ void stage_rc(int b, int& R, int& C) { const int st = b / 1024, sb = b % 1024, swz = sb ^ (((sb >> 9) & 1) << 5); R = (st >> 1) * 16 + swz / 64; C = (st & 1) * 32 + (swz % 64) / 2; }
__host__ __device__ __forceinline__ int perm32(int rho) { const int n = rho >> 4, i = rho & 15; return 8 * (i >> 2) + 4 * n + (i & 3); }

struct Unit { int pm, pn; };
struct Gemm { const bf16_t* A; const bf16_t* Bt; int M, N, K, lda; };

struct StaticOrder {
    int nM, nN, nwg, G, c;
    __device__ void init(int M, int N, int G_, int c_) { nM = M / BM; nN = N / BM; nwg = nM * nN; G = G_; c = c_; }
    __device__ bool next(int i, Unit& u) const {
        const long L = (long)i * G + c; if (L >= nwg) return false;
        int wgid = (int)L; { const int q = nwg / NXCD, r = nwg % NXCD, xcd = wgid % NXCD, off = wgid / NXCD; wgid = (xcd < r ? xcd * (q + 1) : r * (q + 1) + (xcd - r) * q) + off; }
        const int nig = WGM * nN, gid = wgid / nig, fm = gid * WGM, gsz = (nM - fm) < WGM ? (nM - fm) : WGM;
        u.pm = fm + ((wgid % nig) % gsz); u.pn = (wgid % nig) / gsz; return true;
    }
};

typedef f32x4 Acc[2][2][4][2];

template <class Job>
__device__ __forceinline__ void gemm_phase(LAS unsigned char* lds, const Gemm g, const StaticOrder& S, const Job& J) {
    int tid = threadIdx.x; asm volatile("" : "+v"(tid));
    const int wid = __builtin_amdgcn_readfirstlane(tid >> 6), lane = tid & 63, wr = wid >> 2, wc = wid & 3, fr = lane & 15, fq = lane >> 4;
    const int K = g.K, nt = K / BK;
    unsigned voffA[2], voffB[2];
#pragma unroll
    for (int i = 0; i < 2; ++i) { int R, C; stage_rc(tid * 16 + i * 8192, R, C); const int Rb = (R & ~31) + perm32(R & 31);
        voffA[i] = (unsigned)(R * g.lda + C) * 2u; voffB[i] = (unsigned)(Rb * K + C) * 2u; }
    const size_t kstep = (size_t)(BK * 2);
    const unsigned hstepA = (unsigned)(HALF * g.lda * 2), hstepB = (unsigned)(HALF * K * 2);
    const unsigned ldsw = (unsigned)wid * 1024u;
    const int aoff = lds_byte(wr * 64 + fr, fq * 8), boff = lds_byte(wc * 32 + fr, fq * 8);
#define PG8_SA(b, h) (((b) * 2 + (h)) * HTB)
#define PG8_SB(b, h) ((4 + (b) * 2 + (h)) * HTB)
#define PG8_STAGE(bufoff, gbase, voff) do { _Pragma("unroll") for (int _i = 0; _i < 2; ++_i) \
        __builtin_amdgcn_global_load_lds((const unsigned*)((const char*)(gbase) + (voff)[_i]), (LAS unsigned*)(lds + (bufoff) + ldsw + _i * 8192), 16, 0, 0); } while (0)
#define PG8_LDA(dst, b, h) do { _Pragma("unroll") for (int m = 0; m < 4; ++m) _Pragma("unroll") for (int k = 0; k < 2; ++k) dst[m][k] = *(const LAS bf16x8*)(lds + PG8_SA(b, h) + aoff + m * 2048 + k * 1024); } while (0)
#define PG8_LDB(dst, b, h) do { _Pragma("unroll") for (int n = 0; n < 2; ++n) _Pragma("unroll") for (int k = 0; k < 2; ++k) dst[n][k] = *(const LAS bf16x8*)(lds + PG8_SB(b, h) + boff + n * 2048 + k * 1024); } while (0)
#define PG8_MMA(ai, bj, At, Bt) do { __builtin_amdgcn_s_setprio(1); _Pragma("unroll") for (int m = 0; m < 4; ++m) _Pragma("unroll") for (int n = 0; n < 2; ++n) _Pragma("unroll") for (int k = 0; k < 2; ++k) \
        acc[ai][bj][m][n] = __builtin_amdgcn_mfma_f32_16x16x32_bf16(Bt[n][k], At[m][k], acc[ai][bj][m][n], 0, 0, 0); __builtin_amdgcn_s_setprio(0); } while (0)
#define PG8_WAIT_V(n) asm volatile("s_waitcnt vmcnt(" #n ")" ::: "memory")
#define PG8_WAIT_L(n) asm volatile("s_waitcnt lgkmcnt(" #n ")" ::: "memory")
#define PG8_BAR __builtin_amdgcn_s_barrier()
#define PG8_SCHED __builtin_amdgcn_sched_barrier(0)
    Unit cur, nxt; int ui = 0;
    if (!S.next(0, cur)) return;
    Acc acc;
#pragma unroll
    for (int a = 0; a < 2; ++a)
#pragma unroll
        for (int b = 0; b < 2; ++b)
#pragma unroll
            for (int m = 0; m < 4; ++m)
#pragma unroll
                for (int n = 0; n < 2; ++n) acc[a][b][m][n] = (f32x4){0.f, 0.f, 0.f, 0.f};
    bf16x8 At[4][2], B0[2][2], B1[2][2];
    const char* cA; const char* cB; J.ptrs(g, cur, cA, cB);
    PG8_STAGE(PG8_SB(0, 0), cB, voffB); PG8_STAGE(PG8_SB(0, 1), cB + hstepB, voffB); PG8_STAGE(PG8_SA(0, 0), cA, voffA); PG8_STAGE(PG8_SA(0, 1), cA + hstepA, voffA);
    if (wr == 1) PG8_BAR;
    PG8_WAIT_V(2); PG8_BAR;
    PG8_STAGE(PG8_SB(1, 0), cB + kstep, voffB); PG8_STAGE(PG8_SA(1, 0), cA + kstep, voffA); PG8_STAGE(PG8_SB(1, 1), cB + hstepB + kstep, voffB);
    PG8_WAIT_V(6); PG8_BAR;
    for (;;) {
        const bool has_next = S.next(ui + 1, nxt);
        const char* nA = cA; const char* nB = cB; if (has_next) J.ptrs(g, nxt, nA, nB);
        for (int t = 0; t < nt; t += 2) {
            const bool last = (t == nt - 2);
            const char* a1 = cA + (size_t)(t + 1) * kstep;
            const char* a2 = last ? nA : cA + (size_t)(t + 2) * kstep; const char* b2 = last ? nB : cB + (size_t)(t + 2) * kstep;
            const char* a3 = a2 + kstep; const char* b3 = b2 + kstep;
            PG8_LDB(B0, 0, 0); PG8_LDB(B1, 0, 1); PG8_SCHED; PG8_LDA(At, 0, 0); PG8_STAGE(PG8_SA(1, 1), a1 + hstepA, voffA);
            PG8_WAIT_V(8); PG8_WAIT_L(0); PG8_BAR; PG8_MMA(0, 0, At, B0); PG8_MMA(0, 1, At, B1); PG8_BAR; PG8_SCHED;
            PG8_LDA(At, 0, 1); PG8_STAGE(PG8_SB(0, 0), b2, voffB); PG8_STAGE(PG8_SB(0, 1), b2 + hstepB, voffB); PG8_STAGE(PG8_SA(0, 0), a2, voffA);
            PG8_WAIT_V(8); PG8_WAIT_L(0); PG8_BAR; PG8_MMA(1, 0, At, B0); PG8_MMA(1, 1, At, B1); PG8_BAR; PG8_SCHED;
            PG8_LDB(B0, 1, 0); PG8_LDB(B1, 1, 1); PG8_SCHED; PG8_LDA(At, 1, 0); PG8_STAGE(PG8_SA(0, 1), a2 + hstepA, voffA);
            PG8_WAIT_V(8); PG8_WAIT_L(0); PG8_BAR; PG8_MMA(0, 0, At, B0); PG8_MMA(0, 1, At, B1); PG8_BAR; PG8_SCHED;
            PG8_LDA(At, 1, 1); PG8_STAGE(PG8_SB(1, 0), b3, voffB); PG8_STAGE(PG8_SB(1, 1), b3 + hstepB, voffB); PG8_STAGE(PG8_SA(1, 0), a3, voffA);
            PG8_WAIT_V(8); PG8_WAIT_L(0); PG8_BAR; PG8_MMA(1, 0, At, B0); PG8_MMA(1, 1, At, B1); PG8_BAR; PG8_SCHED;
        }
        if (wr == 0) PG8_BAR;
        { int t2 = threadIdx.x; asm volatile("" : "+v"(t2));
          const int w2 = __builtin_amdgcn_readfirstlane(t2 >> 6), l2 = t2 & 63; J.epi(acc, cur, w2 >> 2, w2 & 3, l2 & 15, l2 >> 4); }
        if (!has_next) break;
#pragma unroll
        for (int a = 0; a < 2; ++a)
#pragma unroll
            for (int b = 0; b < 2; ++b)
#pragma unroll
                for (int m = 0; m < 4; ++m)
#pragma unroll
                    for (int n = 0; n < 2; ++n) acc[a][b][m][n] = (f32x4){0.f, 0.f, 0.f, 0.f};
        cur = nxt; cA = nA; cB = nB; ++ui;
        if (wr == 1) PG8_BAR;
    }
    PG8_WAIT_V(0);
    PG8_BAR;
#undef PG8_SA
#undef PG8_SB
#undef PG8_STAGE
#undef PG8_LDA
#undef PG8_LDB
#undef PG8_MMA
#undef PG8_WAIT_V
#undef PG8_WAIT_L
#undef PG8_BAR
#undef PG8_SCHED
}

__device__ __forceinline__ void epi_store_bf16(const Acc& acc, bf16_t* O, int ldc, int row0, int col0, const float* cbias  , float scale) {
    f32x4 bv[2][2];
#pragma unroll
    for (int bj = 0; bj < 2; ++bj)
#pragma unroll
        for (int n = 0; n < 2; ++n) bv[bj][n] = cbias ? *(const f32x4*)(cbias + bj * HALF + 4 * n) : (f32x4){0.f, 0.f, 0.f, 0.f};
#pragma unroll
    for (int ai = 0; ai < 2; ++ai)
#pragma unroll
        for (int m = 0; m < 4; ++m) { bf16_t* rowp = O + (size_t)(row0 + ai * HALF + m * 16) * ldc + col0;
#pragma unroll
            for (int bj = 0; bj < 2; ++bj) st_bf8(rowp + bj * HALF, (acc[ai][bj][m][0] + bv[bj][0]) * scale, (acc[ai][bj][m][1] + bv[bj][1]) * scale); }
}
__device__ __forceinline__ void epi_swiglu(const Acc& acc, bf16_t* H, int row0, int hcol0) {
#pragma unroll
    for (int ai = 0; ai < 2; ++ai)
#pragma unroll
        for (int m = 0; m < 4; ++m) { bf16_t* rowp = H + (size_t)(row0 + ai * HALF + m * 16) * FF_ + hcol0;
            f32x4 h[2];
#pragma unroll
            for (int n = 0; n < 2; ++n)
#pragma unroll
                for (int i = 0; i < 4; ++i) { const float gt = acc[ai][0][m][n][i], up = acc[ai][1][m][n][i]; h[n][i] = gt * fast_sigmoid(gt) * up; }
            st_bf8(rowp, h[0], h[1]); }
}

typedef volatile LAS unsigned long long* PTab;
__device__ __forceinline__ void std_ptrs(const Gemm& g, const Unit& u, const char*& a, const char*& b) {
    a = (const char*)g.A + (size_t)u.pm * BM * g.lda * 2; b = (const char*)g.Bt + (size_t)u.pn * BM * g.K * 2; }
struct JobStd {
    PTab ptab; unsigned o_off; int bias_idx; float scale;
    __device__ __forceinline__ void ptrs(const Gemm& g, const Unit& u, const char*& a, const char*& b) const { std_ptrs(g, u, a, b); }
    __device__ __forceinline__ void epi(const Acc& acc, const Unit& u, int wr, int wc, int fr, int fq) const {
        const int col0 = u.pn * BM + wc * 32 + 8 * fq;
        epi_store_bf16(acc, (bf16_t*)(WSP() + o_off), 1024, u.pm * BM + wr * 64 + fr, col0, bias_idx >= 0 ? INP(bias_idx) + col0 : nullptr, scale); }
};
struct JobSwi {
    PTab ptab;
    __device__ __forceinline__ void ptrs(const Gemm& g, const Unit& u, const char*& a, const char*& b) const { std_ptrs(g, u, a, b); }
    __device__ __forceinline__ void epi(const Acc& acc, const Unit& u, int wr, int wc, int fr, int fq) const {
        epi_swiglu(acc, (bf16_t*)(WSP() + WS_HID), u.pm * BM + wr * 64 + fr, 128 * u.pn + wc * 32 + 8 * fq); }
};
struct JobG3 {
    PTab ptab; int rowbase;
    __device__ __forceinline__ void ptrs(const Gemm& g, const Unit& u, const char*& a, const char*& b) const {
        const int blk = u.pn < 12 ? (u.pn >> 2) : (u.pn - 9);
        a = (const char*)g.A + (size_t)u.pm * BM * g.lda * 2 + (size_t)blk * 2048; b = (const char*)g.Bt + (size_t)u.pn * BM * g.K * 2; }
    __device__ __forceinline__ void epi(const Acc& acc, const Unit& u, int wr, int wc, int fr, int fq) const {
        const int row0 = rowbase + u.pm * BM + wr * 64 + fr;
        if (u.pn < 12) { epi_store_bf16(acc, (bf16_t*)(WSP() + WS_RKV), 3072, row0, u.pn * BM + wc * 32 + 8 * fq, nullptr, 1.0f); return; }
        const int kind = u.pn - 12;
        if (kind < 2 && wc >= 2) return;
        bf16_t* LD = (bf16_t*)(WSP() + WS_LD);
        const int dcol = (kind == 0 ? 0 : (kind == 1 ? 64 : 128)) + wc * 32 + 8 * fq;
#pragma unroll
        for (int ai = 0; ai < 2; ++ai)
#pragma unroll
            for (int m = 0; m < 4; ++m) { f32x4 v[2];
#pragma unroll
                for (int n = 0; n < 2; ++n)
#pragma unroll
                    for (int i = 0; i < 4; ++i) { const float x = acc[ai][0][m][n][i]; v[n][i] = kind == 0 ? fast_tanh(x) : (kind == 1 ? x : fast_sigmoid(x)); }
                st_bf8(LD + (size_t)(row0 + ai * HALF + m * 16) * 256 + dcol, v[0], v[1]); }
    }
};
struct JobG4 {
    PTab ptab;
    __device__ __forceinline__ void ptrs(const Gemm& g, const Unit& u, const char*& a, const char*& b) const { std_ptrs(g, u, a, b); }
    __device__ __forceinline__ void epi(const Acc& acc, const Unit& u, int wr, int wc, int fr, int fq) const {
        const int kind = u.pn >> 2, row0 = u.pm * BM + wr * 64 + fr, col0 = (u.pn & 3) * BM + wc * 32 + 8 * fq;
        unsigned char* ws = WSP();
        if (kind == 2) { epi_store_bf16(acc, (bf16_t*)(ws + WS_G), 1024, row0, col0, nullptr, 1.0f); return; }
        const float* bsrc = kind == 0 ? INP(I_W0) : INP(I_A0); bf16_t* O = (bf16_t*)(ws + (kind == 0 ? WS_DEC : WS_A));
        f32x4 bv[2][2];
#pragma unroll
        for (int bj = 0; bj < 2; ++bj)
#pragma unroll
            for (int n = 0; n < 2; ++n) bv[bj][n] = *(const f32x4*)(bsrc + col0 + bj * HALF + 4 * n);
#pragma unroll
        for (int ai = 0; ai < 2; ++ai)
#pragma unroll
            for (int m = 0; m < 4; ++m)
#pragma unroll
                for (int bj = 0; bj < 2; ++bj) { f32x4 v[2];
#pragma unroll
                    for (int n = 0; n < 2; ++n)
#pragma unroll
                        for (int i = 0; i < 4; ++i) { const float z = acc[ai][bj][m][n][i] + bv[bj][n][i];
                            if (kind == 0) { const float x = -z; const float sp = fmaxf(x, 0.f) + __logf(1.0f + fast_exp(-fabsf(x))); v[n][i] = -fast_exp(-sp - 0.5f); }
                            else v[n][i] = fast_sigmoid(z); }
                    st_bf8(O + (size_t)(row0 + ai * HALF + m * 16) * 1024 + col0 + bj * HALF, v[0], v[1]); }
    }
};
struct JobG8 {
    PTab ptab;
    __device__ __forceinline__ void ptrs(const Gemm& g, const Unit& u, const char*& a, const char*& b) const {
        const char* xa = (const char*)g.A + (size_t)u.pm * BM * g.lda * 2; const char* ws = (const char*)WSP();
        if (u.pn == 1) { a = ws + WS_WKV + (size_t)256 * 1024 * 2; b = xa; }
        else { a = xa; b = u.pn == 0 ? ws + WS_WKV : ws + WS_WIN + 2 * WIN_STRIDE + (size_t)(u.pn - 2) * BM * g.K * 2; } }
    __device__ __forceinline__ void epi(const Acc& acc, const Unit& u, int wr, int wc, int fr, int fq) const {
        const int row0 = u.pm * BM + wr * 64 + fr; unsigned char* ws = WSP();
        if (u.pn >= 2) { epi_swiglu(acc, (bf16_t*)(ws + WS_HID), row0, 128 * (u.pn - 2) + wc * 32 + 8 * fq); return; }
        const float* bkv = INP(I_BKV);
        if (u.pn == 0) { const int col0 = wc * 32 + 8 * fq; epi_store_bf16(acc, (bf16_t*)(ws + WS_KB), 256, row0, col0, bkv + col0, 1.0f); return; }
        bf16_t* VT = (bf16_t*)(ws + WS_VT);
        const int r0 = wr * 64 + fr, c0 = u.pm * BM + wc * 32 + 8 * fq;
#pragma unroll
        for (int ai = 0; ai < 2; ++ai)
#pragma unroll
            for (int m = 0; m < 4; ++m) { const int r = r0 + ai * HALF + m * 16; const float bb = bkv[256 + r];
#pragma unroll
                for (int bj = 0; bj < 2; ++bj) st_bf8(VT + (size_t)r * M_ + c0 + bj * HALF, acc[ai][bj][m][0] + bb, acc[ai][bj][m][1] + bb); }
    }
};
}

struct Args { const float* in[28]; float* out; unsigned char* ws; int stop; int pad; };

__device__ __forceinline__ void tr_item(const float* W, int N, int k0, int n0, bf16_t* dst  , int ldk, const float* gain  , LAS float* scr, int lane) {
    float v[32];
    const float* src = W + (size_t)(k0 + (lane >> 5)) * N + n0 + (lane & 31);
#pragma unroll
    for (int i = 0; i < 32; ++i) v[i] = src[(size_t)(2 * i) * N];
#pragma unroll
    for (int i = 0; i < 32; ++i) scr[(2 * i + (lane >> 5)) * 33 + (lane & 31)] = v[i];
    asm volatile("s_waitcnt lgkmcnt(0)" ::: "memory");
    const int c = lane & 7;
    f32x4 g0 = (f32x4){1.f, 1.f, 1.f, 1.f}, g1 = g0;
    if (gain) { g0 = *(const f32x4*)(gain + 8 * c); g1 = *(const f32x4*)(gain + 8 * c + 4); }
#pragma unroll
    for (int j = 0; j < 4; ++j) { const int n = (lane >> 3) + 8 * j; const LAS float* s = scr + (8 * c) * 33 + n;
        u32x4 o; o.x = cvt_pk_bf16(s[0 * 33] * g0[0], s[1 * 33] * g0[1]); o.y = cvt_pk_bf16(s[2 * 33] * g0[2], s[3 * 33] * g0[3]);
        o.z = cvt_pk_bf16(s[4 * 33] * g1[0], s[5 * 33] * g1[1]); o.w = cvt_pk_bf16(s[6 * 33] * g1[2], s[7 * 33] * g1[3]);
        *(u32x4*)(dst + (size_t)n * ldk + 8 * c) = o; }
    asm volatile("s_waitcnt lgkmcnt(0)" ::: "memory");
}

__device__ __forceinline__ float sumsq4(const f32x4 (&v)[4]) { float s = 0.f;
#pragma unroll
    for (int j = 0; j < 4; ++j) s += (v[j][0] * v[j][0] + v[j][1] * v[j][1]) + (v[j][2] * v[j][2] + v[j][3] * v[j][3]);
    return s; }

__device__ __forceinline__ void run_phase(const int ph, volatile LAS unsigned long long* ptab0, LAS unsigned char* lds, const bool dry = false) {
    {
        int tid = threadIdx.x; asm volatile("" : "+v"(tid));
        volatile LAS unsigned long long* ptab = ptab0; asm volatile("" : "+s"(ptab));
        int G = gridDim.x, bx = blockIdx.x; asm volatile("" : "+s"(G), "+s"(bx));
        const int lane = tid & 63, wave = __builtin_amdgcn_readfirstlane(tid >> 6);
        const int vcu = (G % 8 == 0) ? (bx % 8) * (G / 8) + bx / 8 : bx;
        const int gw = vcu * NWAVES + wave, NGW = G * NWAVES;
        unsigned char* ws = (unsigned char*)ldp(ptab, 29);
        float* HA = (float*)ldp(ptab, 28);
        const float* normg = INP(I_NORMG);
        bf16_t* F = (bf16_t*)(ws + WS_F); bf16_t* XN = (bf16_t*)(ws + WS_XN); bf16_t* HID = (bf16_t*)(ws + WS_HID);
        if (ph == 0) {
            LAS float* scr = (LAS float*)(lds + wave * 16384);
            constexpr int NITEMS = 20480;
            for (int it = gw; it < NITEMS; it += NGW) {
                int r = it; const float* W; int N; bf16_t* dst; int ldk; const float* gain = nullptr; int mode = 0;
                if (r < 11264) { const int f = r / 2816; r -= f * 2816; W = INP(I_WIN) + (size_t)f * 1024 * 5632; N = 5632; dst = (bf16_t*)(ws + WS_WIN + f * WIN_STRIDE); ldk = 1024; mode = 1;
                    gain = normg + ((f >> 1) * 6 + ((f & 1) ? 4 : 0)) * 1024; }
                else if ((r -= 11264) < 5632) { const int f = r / 1408; r -= f * 1408; W = INP(I_WOUT) + (size_t)f * 2816 * 1024; N = 1024; dst = (bf16_t*)(ws + WS_WOUT + f * WOUT_STRIDE); ldk = 2816; }
                else if ((r -= 5632) < 1536) { const int c = r / 512; r -= c * 512; W = INP(I_WRKV) + (size_t)c * 1024 * 1024; N = 1024; dst = (bf16_t*)(ws + WS_B3) + (size_t)c * 1024 * 1024; ldk = 1024; }
                else if ((r -= 1536) < 32) { W = INP(I_W1); N = 64; dst = (bf16_t*)(ws + WS_B3) + (size_t)3072 * 1024; ldk = 1024; }
                else if ((r -= 32) < 32) { W = INP(I_A1); N = 64; dst = (bf16_t*)(ws + WS_B3) + (size_t)3328 * 1024; ldk = 1024; }
                else if ((r -= 32) < 64) { W = INP(I_G1); N = 128; dst = (bf16_t*)(ws + WS_B3) + (size_t)3584 * 1024; ldk = 1024; }
                else if ((r -= 64) < 32) { W = INP(I_W2); N = 1024; dst = (bf16_t*)(ws + WS_LUP); ldk = 256; }
                else if ((r -= 32) < 32) { W = INP(I_A2); N = 1024; dst = (bf16_t*)(ws + WS_LUP) + (size_t)1024 * 256 + 64; ldk = 256; }
                else if ((r -= 32) < 64) { W = INP(I_G2); N = 1024; dst = (bf16_t*)(ws + WS_LUP) + (size_t)2048 * 256 + 128; ldk = 256; }
                else if ((r -= 64) < 512) { W = INP(I_RWO); N = 1024; dst = (bf16_t*)(ws + WS_RWO); ldk = 1024; }
                else if ((r -= 512) < 256) { W = INP(I_WKV); N = 512; dst = (bf16_t*)(ws + WS_WKV); ldk = 1024; gain = INP(I_KVG); }
                else if ((r -= 256) < 512) { W = INP(I_WQ); N = 1024; dst = (bf16_t*)(ws + WS_WQ); ldk = 1024; gain = normg + (6 + 2) * 1024; }
                else { r -= 512; W = INP(I_AWO); N = 1024; dst = (bf16_t*)(ws + WS_AWO); ldk = 1024; }
                const int nblk = N / 32, kb = r / nblk, nb = r % nblk, k0 = 64 * kb, n0 = 32 * nb;
                int drow = n0;
                if (mode == 1) drow = n0 < FF_ ? (n0 >> 7) * 256 + (n0 & 127) : ((n0 - FF_) >> 7) * 256 + 128 + ((n0 - FF_) & 127);
                tr_item(W, N, k0, n0, dst + (size_t)drow * ldk + k0, ldk, gain ? gain + k0 : nullptr, scr, lane);
            }
            const float* x = INP(I_X);
            for (int row = gw; row < M_; row += NGW) {
                f32x4 v[4];
#pragma unroll
                for (int j = 0; j < 4; ++j) v[j] = *(const f32x4*)(x + (size_t)row * D_ + 4 * lane + 256 * j);
                const float rs = rsqrtf(wave_sum(sumsq4(v)) * (1.0f / D_) + RMS_EPS);
#pragma unroll
                for (int j = 0; j < 4; ++j) st_bf4(XN + (size_t)row * D_ + 4 * lane + 256 * j, v[j] * rs);
            }
        }
        else if (ph == 1 || ph == 12 || ph == 22) {
            const int f = ph == 1 ? 0 : (ph == 12 ? 1 : 3);
            pg8::Gemm g{XN, (const bf16_t*)(ws + WS_WIN + f * WIN_STRIDE), M_, 2 * FF_, D_, D_};
            pg8::StaticOrder S; S.init(M_, 2 * FF_, G, bx);
            pg8::JobSwi J{ptab};
            pg8::gemm_phase<pg8::JobSwi>(lds, g, S, J);
        }
        else if (ph == 2 || ph == 13 || ph == 16 || ph == 23 || ph == 10 || ph == 18 || ph == 20) {
            pg8::Gemm g; pg8::JobStd J;
            if (ph == 10) { g = pg8::Gemm{(const bf16_t*)(ws + WS_YG), (const bf16_t*)(ws + WS_RWO), M_, D_, D_, D_}; J = pg8::JobStd{ptab, (unsigned)WS_F, -1, 1.0f}; }
            else if (ph == 18) { g = pg8::Gemm{XN, (const bf16_t*)(ws + WS_WQ), M_, D_, D_, D_}; J = pg8::JobStd{ptab, (unsigned)WS_Q, I_BQ, QSCALE}; }
            else if (ph == 20) { g = pg8::Gemm{(const bf16_t*)(ws + WS_O), (const bf16_t*)(ws + WS_AWO), M_, D_, D_, D_}; J = pg8::JobStd{ptab, (unsigned)WS_F, I_BO, 1.0f}; }
            else { const int f = ph == 2 ? 0 : (ph == 13 ? 1 : (ph == 16 ? 2 : 3));
                g = pg8::Gemm{HID, (const bf16_t*)(ws + WS_WOUT + f * WOUT_STRIDE), M_, D_, FF_, FF_}; J = pg8::JobStd{ptab, (unsigned)WS_F, -1, 1.0f}; }
            pg8::StaticOrder S; S.init(M_, D_, G, bx);
            pg8::gemm_phase<pg8::JobStd>(lds, g, S, J);
        }
        else if (ph == 3 || ph == 5) {
            const int hb = ph == 3 ? 0 : 1;
            LAS float* mus = (LAS float*)lds;
            for (int e = tid; e < 6 * 1024; e += NTHR) { const int c = e >> 10; const int src = c == 0 ? 0 : (c == 1 ? 2 : (c == 2 ? 3 : (c == 3 ? 1 : c))); mus[e] = INP(I_MU)[src * 1024 + (e & 1023)]; }
            __syncthreads();
            const float* x = INP(I_X); bf16_t* X6 = (bf16_t*)(ws + WS_X6);
            f32x4 g1[4], g2[4];
#pragma unroll
            for (int j = 0; j < 4; ++j) { g1[j] = *(const f32x4*)(normg + 1 * 1024 + 4 * lane + 256 * j) * (dry ? 0.0f : 0.5f); g2[j] = *(const f32x4*)(normg + 2 * 1024 + 4 * lane + 256 * j); }
            const int r0 = 8192 * hb + 4 * gw;
            f32x4 up[4];
#pragma unroll
            for (int j = 0; j < 4; ++j) up[j] = (f32x4){0.f, 0.f, 0.f, 0.f};
            for (int rr = ((r0 & (T_ - 1)) ? -1 : 0); rr < 4; ++rr) {
                const int row = r0 + rr;
                f32x4 fv[4], h[4];
#pragma unroll
                for (int j = 0; j < 4; ++j) { fv[j] = ld_bf4(F + (size_t)row * D_ + 4 * lane + 256 * j); h[j] = *(const f32x4*)(x + (size_t)row * D_ + 4 * lane + 256 * j); }
                const float rs1 = rsqrtf(wave_sum(sumsq4(fv)) * (1.0f / D_) + RMS_EPS);
#pragma unroll
                for (int j = 0; j < 4; ++j) h[j] = h[j] + fv[j] * rs1 * g1[j];
                const float rs2 = rsqrtf(wave_sum(sumsq4(h)) * (1.0f / D_) + RMS_EPS);
                if (rr >= 0) {
#pragma unroll
                    for (int j = 0; j < 4; ++j) *(f32x4*)(HA + (size_t)row * D_ + 4 * lane + 256 * j) = h[j];
                }
#pragma unroll
                for (int j = 0; j < 4; ++j) { const f32x4 u = h[j] * rs2 * g2[j];
                    if (rr >= 0) { const f32x4 xx = up[j] - u; bf16_t* dstp = X6 + (size_t)(row - 8192 * hb) * 6144 + 4 * lane + 256 * j;
#pragma unroll
                        for (int c = 0; c < 6; ++c) st_bf4(dstp + c * 1024, u + xx * *(const LAS f32x4*)(mus + c * 1024 + 4 * lane + 256 * j)); }
                    up[j] = u; }
            }
        }
        else if (ph == 4 || ph == 6) {
            const int hb = ph == 4 ? 0 : 1;
            pg8::Gemm g{(const bf16_t*)(ws + WS_X6), (const bf16_t*)(ws + WS_B3), 8192, 3840, D_, 6144};
            pg8::StaticOrder S; S.init(8192, 3840, G, bx);
            pg8::JobG3 J{ptab, 8192 * hb};
            pg8::gemm_phase<pg8::JobG3>(lds, g, S, J);
        }
        else if (ph == 7) {
            pg8::Gemm g{(const bf16_t*)(ws + WS_LD), (const bf16_t*)(ws + WS_LUP), M_, 3072, 256, 256};
            pg8::StaticOrder S; S.init(M_, 3072, G, bx);
            pg8::JobG4 J{ptab};
            pg8::gemm_phase<pg8::JobG4>(lds, g, S, J);
        }
        else if (ph == 8) {
            constexpr int TC = 32, NCH = T_ / TC;
            constexpr int BUFB = TC * 1280 + TC * 64 + TC * 64;
            const int bh = vcu >> 2, rq = vcu & 3, bb = bh >> 4, hh = bh & 15;
            const bf16_t* RKV = (const bf16_t*)(ws + WS_RKV); const bf16_t* DEC = (const bf16_t*)(ws + WS_DEC); const bf16_t* Aa = (const bf16_t*)(ws + WS_A);
            float* Y = (float*)(ws + WS_Y);
            const size_t rowbase = (size_t)bb * T_;
            if (vcu < 256) {
            if (wave < 4) {
                const int ri = lane >> 4, j4 = lane & 15;
                float S0 = 0.f, S1 = 0.f, S2 = 0.f, S3 = 0.f;
                __syncthreads();
                for (int ci = 0; ci < NCH; ++ci) {
                    const LAS unsigned char* buf = lds + (ci & 1) * BUFB;
                    const LAS float* vb = (const LAS float*)(buf + TC * 1280) + wave * 4 + ri;
                    LAS float* yb = (LAS float*)(buf + TC * 1280 + TC * 64) + wave * 4 + ri;
#pragma unroll 8
                    for (int s = 0; s < TC; ++s) {
                        const LAS unsigned char* p = buf + s * 1280 + j4 * 16;
                        const f32x4 nk = *(const LAS f32x4*)(p), w = *(const LAS f32x4*)(p + 256), b = *(const LAS f32x4*)(p + 512), k = *(const LAS f32x4*)(p + 768), r = *(const LAS f32x4*)(p + 1024);
                        const float v = vb[s * 16];
                        float sa = (S0 * nk[0] + S1 * nk[1]) + (S2 * nk[2] + S3 * nk[3]);
                        sa = rowsum16(sa);
                        S0 = S0 * w[0] + (sa * b[0] + v * k[0]); S1 = S1 * w[1] + (sa * b[1] + v * k[1]);
                        S2 = S2 * w[2] + (sa * b[2] + v * k[2]); S3 = S3 * w[3] + (sa * b[3] + v * k[3]);
                        float y = (S0 * r[0] + S1 * r[1]) + (S2 * r[2] + S3 * r[3]);
                        y = rowsum16(y);
                        if (j4 == 0) yb[s * 16] = y;
                    }
                    __syncthreads();
                }
            } else {
                const int lw = wave - 4, ss = lane >> 4, j4 = lane & 15;
                const f32x4 kk4 = *(const f32x4*)(INP(I_KK) + hh * 64 + 4 * j4), ka4 = *(const f32x4*)(INP(I_KA) + hh * 64 + 4 * j4);
                const int e = lw * 128 + lane * 2, es = e >> 4, ei = e & 15;
                for (int ci = -1; ci < NCH; ++ci) {
                    if (ci > 0) {
                        const LAS unsigned char* buf = lds + ((ci - 1) & 1) * BUFB;
                        const f32x2 yv = *(const LAS f32x2*)(buf + TC * 1280 + TC * 64 + (es * 16 + ei) * 4);
                        *(f32x2*)(Y + (rowbase + (size_t)(ci - 1) * TC + es) * D_ + hh * 64 + rq * 16 + ei) = yv;
                    }
                    if (ci + 1 < NCH) {
                        LAS unsigned char* buf = lds + ((ci + 1) & 1) * BUFB;
                        const size_t t0 = rowbase + (size_t)(ci + 1) * TC;
#pragma unroll
                        for (int it = 0; it < 2; ++it) {
                            const int s = lw * 8 + it * 4 + ss; const size_t row = t0 + s;
                            const f32x4 r4 = ld_bf4(RKV + row * 3072 + hh * 64 + 4 * j4), k4 = ld_bf4(RKV + row * 3072 + 1024 + hh * 64 + 4 * j4);
                            const f32x4 a4 = ld_bf4(Aa + row * D_ + hh * 64 + 4 * j4), d4 = ld_bf4(DEC + row * D_ + hh * 64 + 4 * j4);
                            const f32x4 kk = k4 * kk4;
                            float q = (kk[0] * kk[0] + kk[1] * kk[1]) + (kk[2] * kk[2] + kk[3] * kk[3]);
                            q = rowsum16(q);
                            const float inv = 1.0f / fmaxf(sqrtf(q), 1e-12f);
                            const f32x4 kn = kk * inv;
                            f32x4 wv; wv[0] = fast_exp(d4[0]); wv[1] = fast_exp(d4[1]); wv[2] = fast_exp(d4[2]); wv[3] = fast_exp(d4[3]);
                            LAS unsigned char* p = buf + s * 1280 + j4 * 16;
                            *(LAS f32x4*)(p) = -kn; *(LAS f32x4*)(p + 256) = wv; *(LAS f32x4*)(p + 512) = kn * a4;
                            *(LAS f32x4*)(p + 768) = k4 * (1.0f + (a4 - 1.0f) * ka4); *(LAS f32x4*)(p + 1024) = r4;
                        }
                        const unsigned vv = *(const unsigned*)(RKV + (t0 + es) * 3072 + 2048 + hh * 64 + rq * 16 + ei);
                        *(LAS f32x2*)(buf + TC * 1280 + (es * 16 + ei) * 4) = (f32x2){bf_lo(vv), bf_hi(vv)};
                    }
                    __syncthreads();
                }
                {
                    const LAS unsigned char* buf = lds + ((NCH - 1) & 1) * BUFB;
                    const f32x2 yv = *(const LAS f32x2*)(buf + TC * 1280 + TC * 64 + (es * 16 + ei) * 4);
                    *(f32x2*)(Y + (rowbase + (size_t)(NCH - 1) * TC + es) * D_ + hh * 64 + rq * 16 + ei) = yv;
                }
            }
            }
        }
        else if (ph == 9) {
            const bf16_t* RKV = (const bf16_t*)(ws + WS_RKV); const bf16_t* Aa = (const bf16_t*)(ws + WS_A); const bf16_t* Gg = (const bf16_t*)(ws + WS_G);
            const float* Y = (const float*)(ws + WS_Y); bf16_t* YG = (bf16_t*)(ws + WS_YG);
            for (int row = gw; row < M_; row += NGW) {
#pragma unroll
                for (int j = 0; j < 4; ++j) {
                    const int col = 4 * lane + 256 * j;
                    const f32x4 y = *(const f32x4*)(Y + (size_t)row * D_ + col);
                    const f32x4 r4 = ld_bf4(RKV + (size_t)row * 3072 + col), k4 = ld_bf4(RKV + (size_t)row * 3072 + 1024 + col), v4 = ld_bf4(RKV + (size_t)row * 3072 + 2048 + col);
                    const f32x4 a4 = ld_bf4(Aa + (size_t)row * D_ + col), g4 = ld_bf4(Gg + (size_t)row * D_ + col);
                    const f32x4 ka = *(const f32x4*)(INP(I_KA) + col), rk = *(const f32x4*)(INP(I_RK) + col);
                    const f32x4 gg = *(const f32x4*)(INP(I_GNG) + col), gb = *(const f32x4*)(INP(I_GNB) + col);
                    const float mean = rowsum16((y[0] + y[1]) + (y[2] + y[3])) * (1.0f / 64.0f);
                    const f32x4 dy = y - mean;
                    const float var = rowsum16((dy[0] * dy[0] + dy[1] * dy[1]) + (dy[2] * dy[2] + dy[3] * dy[3])) * (1.0f / 64.0f);
                    const float rstd = rsqrtf(var + GN_EPS);
                    const f32x4 kp = k4 * (1.0f + (a4 - 1.0f) * ka);
                    const f32x4 t = r4 * kp * rk;
                    const float bon = rowsum16((t[0] + t[1]) + (t[2] + t[3]));
                    st_bf4(YG + (size_t)row * D_ + col, (dy * rstd * gg + gb + v4 * bon) * g4);
                }
            }
        }
        else if (ph == 11 || ph == 14 || ph == 17 || ph == 21 || ph == 24) {
            const int gi = ph == 11 ? 3 : (ph == 14 ? 5 : (ph == 17 ? 7 : (ph == 21 ? 9 : 11)));
            const float c = dry ? 0.0f : ((ph == 11 || ph == 21) ? 1.0f : 0.5f);
            const bool want_xn = ph != 24;
            f32x4 ga[4];
#pragma unroll
            for (int j = 0; j < 4; ++j) ga[j] = *(const f32x4*)(normg + gi * 1024 + 4 * lane + 256 * j) * c;
            for (int row = gw; row < M_; row += NGW) {
                f32x4 fv[4], h[4];
#pragma unroll
                for (int j = 0; j < 4; ++j) { fv[j] = ld_bf4(F + (size_t)row * D_ + 4 * lane + 256 * j); h[j] = *(const f32x4*)(HA + (size_t)row * D_ + 4 * lane + 256 * j); }
                const float rs1 = rsqrtf(wave_sum(sumsq4(fv)) * (1.0f / D_) + RMS_EPS);
#pragma unroll
                for (int j = 0; j < 4; ++j) { h[j] = h[j] + fv[j] * rs1 * ga[j]; *(f32x4*)(HA + (size_t)row * D_ + 4 * lane + 256 * j) = h[j]; }
                if (want_xn) {
                    const float rs2 = rsqrtf(wave_sum(sumsq4(h)) * (1.0f / D_) + RMS_EPS);
#pragma unroll
                    for (int j = 0; j < 4; ++j) st_bf4(XN + (size_t)row * D_ + 4 * lane + 256 * j, h[j] * rs2);
                }
            }
        }
        else if (ph == 15) {
            pg8::Gemm g{XN, nullptr, M_, 2 * FF_ + 512, D_, D_};
            pg8::StaticOrder S; S.init(M_, 2 * FF_ + 512, G, bx);
            pg8::JobG8 J{ptab};
            pg8::gemm_phase<pg8::JobG8>(lds, g, S, J);
        }
        else if (ph == 19) {
            const bf16_t* Q = (const bf16_t*)(ws + WS_Q); const bf16_t* KB = (const bf16_t*)(ws + WS_KB); const bf16_t* VT = (const bf16_t*)(ws + WS_VT); bf16_t* O = (bf16_t*)(ws + WS_O);
            LAS bf16_t* Ks = (LAS bf16_t*)lds;
            LAS bf16_t* Vs = (LAS bf16_t*)(lds + 36864);
            const int fr = lane & 15, fq = lane >> 4;
            for (int unit = vcu; unit < 512; unit += G) {
                const int nb = unit & 31, kvh = (unit >> 5) & 3, bb = unit >> 7;
                const size_t rowbase = (size_t)bb * T_; const int t0 = 128 * (nb - 1);
                __syncthreads();
#pragma unroll
                for (int i = 0; i < 4; ++i) { const int c = tid + NTHR * i; const int key = c >> 3, part = c & 7;
                    u32x4 v = (u32x4){0u, 0u, 0u, 0u};
                    if (nb > 0 || key >= 128) v = *(const u32x4*)(KB + (rowbase + t0 + key) * 256 + kvh * 64 + part * 8);
                    *(LAS u32x4*)(Ks + key * 72 + part * 8) = v; }
#pragma unroll
                for (int i = 0; i < 4; ++i) { const int c = tid + NTHR * i; const int d = c >> 5, part = c & 31;
                    u32x4 v = (u32x4){0u, 0u, 0u, 0u};
                    if (nb > 0 || part >= 16) v = *(const u32x4*)(VT + (size_t)(kvh * 64 + d) * M_ + rowbase + t0 + part * 8);
                    *(LAS u32x4*)(Vs + d * 264 + part * 8) = v; }
                __syncthreads();
                const int gi = wave >> 1, qh = wave & 1, hq = kvh * 4 + gi;
                const float sink = INP(I_SINK)[hq] * LOG2E;
                for (int qt = 0; qt < 4; ++qt) {
                    const int qo = 64 * qh + 16 * qt, kt0 = qo >> 4;
                    const size_t qrow = rowbase + 128 * nb + qo + fr;
                    bf16x8 bq[2];
#pragma unroll
                    for (int ks = 0; ks < 2; ++ks) bq[ks] = *(const bf16x8*)(Q + qrow * D_ + hq * 64 + 32 * ks + 8 * fq);
                    f32x4 sc[9];
#pragma unroll
                    for (int i = 0; i < 9; ++i) { sc[i] = (f32x4){0.f, 0.f, 0.f, 0.f};
#pragma unroll
                        for (int ks = 0; ks < 2; ++ks) { const bf16x8 ka = *(const LAS bf16x8*)(Ks + (16 * (kt0 + i) + fr) * 72 + 32 * ks + 8 * fq);
                            sc[i] = __builtin_amdgcn_mfma_f32_16x16x32_bf16(ka, bq[ks], sc[i], 0, 0, 0); } }
                    const int qw = 128 + qo + fr;
                    float mx = sink;
#pragma unroll
                    for (int i = 0; i < 9; ++i)
#pragma unroll
                        for (int r = 0; r < 4; ++r) { const int kw = 16 * (kt0 + i) + 4 * fq + r; const bool ok = (kw <= qw) && (qw - kw < 128) && (nb > 0 || kw >= 128);
                            sc[i][r] = ok ? sc[i][r] : -1e30f; mx = fmaxf(mx, sc[i][r]); }
                    mx = fmaxf(mx, xlane(mx, lane ^ 16)); mx = fmaxf(mx, xlane(mx, lane ^ 32));
                    float ls = 0.f; bf16x4 pb[9];
#pragma unroll
                    for (int i = 0; i < 9; ++i) { f32x4 p;
#pragma unroll
                        for (int r = 0; r < 4; ++r) { p[r] = __builtin_amdgcn_exp2f(sc[i][r] - mx); ls += p[r]; }
                        u32x2 w; w.x = cvt_pk_bf16(p[0], p[1]); w.y = cvt_pk_bf16(p[2], p[3]); pb[i] = __builtin_bit_cast(bf16x4, w); }
                    ls += xlane(ls, lane ^ 16); ls += xlane(ls, lane ^ 32);
                    ls += __builtin_amdgcn_exp2f(sink - mx);
                    const float inv = 1.0f / ls;
#pragma unroll
                    for (int dt = 0; dt < 4; ++dt) { f32x4 o = (f32x4){0.f, 0.f, 0.f, 0.f};
#pragma unroll
                        for (int i = 0; i < 9; ++i) { const bf16x4 va = *(const LAS bf16x4*)(Vs + (16 * dt + fr) * 264 + 16 * (kt0 + i) + 4 * fq);
                            o = __builtin_amdgcn_mfma_f32_16x16x16bf16_1k(va, pb[i], o, 0, 0, 0); }
                        st_bf4(O + qrow * D_ + hq * 64 + 16 * dt + 4 * fq, o * inv); }
                }
            }
        }
    }
}
__global__ void __launch_bounds__(NTHR, 2) fwd_kernel(Args args) {
    extern __shared__ __attribute__((aligned(16))) unsigned char lds_raw[];
    cg::grid_group grid = cg::this_grid();
    LAS unsigned char* lds = (LAS unsigned char*)lds_raw;
    const int tid0 = threadIdx.x;
    volatile LAS unsigned long long* ptab0 = (volatile LAS unsigned long long*)(lds + PTAB_OFF);
    { volatile LAS unsigned long long* ptab = ptab0;
    if (tid0 == 0) {
#pragma unroll
        for (int i = 0; i < 28; ++i) ptab[i] = (unsigned long long)args.in[i];
        ptab[28] = (unsigned long long)args.out; ptab[29] = (unsigned long long)args.ws; ptab[30] = (unsigned long long)args.stop;
    }
    __syncthreads(); }
    const int nph = (int)ldp(ptab0, 30);
#ifndef PROBE_MASK
#define PROBE_MASK 0x0u
#endif
#ifndef PROBE_SYNC
#define PROBE_SYNC 0
#endif
#define RP(k) if (nph <= (k)) return; if (PROBE_SYNC) grid.sync(); if ((PROBE_MASK >> (k)) & 1u) { run_phase((k), ptab0, lds, true); grid.sync(); } run_phase((k), ptab0, lds); if (nph > (k) + 1) grid.sync();
    RP(0) RP(1) RP(2) RP(3) RP(4) RP(5) RP(6) RP(7) RP(8) RP(9) RP(10) RP(11) RP(12) RP(13) RP(14) RP(15) RP(16) RP(17) RP(18) RP(19) RP(20) RP(21) RP(22) RP(23) RP(24)
#undef RP
}

extern "C" void kernel_launch(void* const* d_in, const int* in_sizes, int n_in, void* d_out, int out_size, void* d_ws, size_t ws_size, hipStream_t stream) {
    static int grid = 0;
    if (grid == 0) {
        if (n_in != 28 || out_size != M_ * D_ || ws_size < WS_END) { fprintf(stderr, "kernel_launch: unexpected problem (n_in %d out %d ws %zu)\n", n_in, out_size, ws_size); grid = -1; return; }
        int dev = 0, cus = 0, per_cu = 0;
        (void)hipGetDevice(&dev); (void)hipDeviceGetAttribute(&cus, hipDeviceAttributeMultiprocessorCount, dev);
        if (hipFuncSetAttribute((const void*)fwd_kernel, hipFuncAttributeMaxDynamicSharedMemorySize, LDS_BYTES) != hipSuccess) { fprintf(stderr, "kernel_launch: hipFuncSetAttribute failed\n"); grid = -1; return; }
        if (hipOccupancyMaxActiveBlocksPerMultiprocessor(&per_cu, (const void*)fwd_kernel, NTHR, LDS_BYTES) != hipSuccess || per_cu < 1) { fprintf(stderr, "kernel_launch: occupancy query says %d\n", per_cu); per_cu = 1; }
        (void)hipGetLastError();
        grid = cus * 1;
        if (grid > 256) grid = 256;
    }
    if (grid < 0) return;
    (void)hipMemsetAsync((char*)d_ws + WS_B3 + (size_t)3072 * 1024 * 2, 0, (size_t)768 * 1024 * 2, stream);
    (void)hipMemsetAsync((char*)d_ws + WS_LUP, 0, (size_t)3072 * 256 * 2, stream);
    Args a{};
    for (int i = 0; i < 28; ++i) a.in[i] = (const float*)d_in[i];
    a.out = (float*)d_out; a.ws = (unsigned char*)d_ws; a.stop = 25; a.pad = 0;
    void* kargs[] = {&a};
    hipError_t e = hipLaunchCooperativeKernel((const void*)fwd_kernel, dim3(grid), dim3(NTHR), kargs, LDS_BYTES, stream);
    if (e != hipSuccess) fprintf(stderr, "kernel_launch: cooperative launch failed: %s (grid %d)\n", hipGetErrorString(e), grid);
}
```

```cpp
#include <hip/hip_runtime.h>
#include <hip/hip_cooperative_groups.h>
#include <cstdio>
#include <cstdint>
namespace cg = cooperative_groups;

#define LAS __attribute__((address_space(3)))
typedef unsigned short bf16_t;
typedef short bf16x8 __attribute__((ext_vector_type(8)));
typedef short bf16x4 __attribute__((ext_vector_type(4)));
typedef float f32x4 __attribute__((ext_vector_type(4)));
typedef float f32x2 __attribute__((ext_vector_type(2)));
typedef unsigned u32x4 __attribute__((ext_vector_type(4)));
typedef unsigned u32x2 __attribute__((ext_vector_type(2)));

constexpr int T_ = 4096, D_ = 1024, M_ = 16384, FF_ = 2816;
constexpr float RMS_EPS = 1e-6f, GN_EPS = 64e-5f;
constexpr float LOG2E = 1.4426950408889634f;
constexpr float QSCALE = 0.125f * LOG2E;
constexpr int NWAVES = 8, NTHR = 512;
constexpr int LDS_BYTES = 135168;

constexpr size_t MiB = 1u << 20;
constexpr size_t WS_WIN = 1 * MiB;
constexpr size_t WIN_STRIDE = 11 * MiB;
constexpr size_t WS_WOUT = 45 * MiB;
constexpr size_t WOUT_STRIDE = 5 * MiB + MiB / 2;
constexpr size_t WS_B3 = 67 * MiB;
constexpr size_t WS_LUP = 74 * MiB + MiB / 2;
constexpr size_t WS_RWO = 76 * MiB;
constexpr size_t WS_WKV = 78 * MiB;
constexpr size_t WS_WQ = 79 * MiB;
constexpr size_t WS_AWO = 81 * MiB;
constexpr size_t WS_F = 84 * MiB;
constexpr size_t WS_XN = 116 * MiB;
constexpr size_t WS_HID = 148 * MiB;
constexpr size_t WS_KB = 236 * MiB;
constexpr size_t WS_VT = 244 * MiB;
constexpr size_t WS_Q = 252 * MiB;
constexpr size_t WS_O = 284 * MiB;
constexpr size_t WS_X6 = 148 * MiB;
constexpr size_t WS_RKV = 244 * MiB;
constexpr size_t WS_LD = 340 * MiB;
constexpr size_t WS_DEC = 148 * MiB;
constexpr size_t WS_A = 180 * MiB;
constexpr size_t WS_G = 212 * MiB;
constexpr size_t WS_Y = 84 * MiB;
constexpr size_t WS_YG = 148 * MiB;
constexpr size_t WS_END = 352 * MiB;

__device__ __forceinline__ unsigned cvt_pk_bf16(float lo, float hi) { unsigned r; asm volatile("v_cvt_pk_bf16_f32 %0, %1, %2" : "=v"(r) : "v"(lo), "v"(hi)); return r; }
__device__ __forceinline__ float bf_lo(unsigned w) { return __builtin_bit_cast(float, w << 16); }
__device__ __forceinline__ float bf_hi(unsigned w) { return __builtin_bit_cast(float, w & 0xffff0000u); }
__device__ __forceinline__ f32x4 ld_bf4(const bf16_t* p) { const u32x2 w = *(const u32x2*)p; return (f32x4){bf_lo(w.x), bf_hi(w.x), bf_lo(w.y), bf_hi(w.y)}; }
__device__ __forceinline__ void st_bf4(bf16_t* p, f32x4 v) { u32x2 w; w.x = cvt_pk_bf16(v[0], v[1]); w.y = cvt_pk_bf16(v[2], v[3]); *(u32x2*)p = w; }
__device__ __forceinline__ void st_bf8(bf16_t* p, f32x4 v0, f32x4 v1) { u32x4 w; w.x = cvt_pk_bf16(v0[0], v0[1]); w.y = cvt_pk_bf16(v0[2], v0[3]); w.z = cvt_pk_bf16(v1[0], v1[1]); w.w = cvt_pk_bf16(v1[2], v1[3]); *(u32x4*)p = w; }
#define DPP_ADD(x, ctrl) x += __builtin_bit_cast(float, __builtin_amdgcn_update_dpp(0, __builtin_bit_cast(int, x), ctrl, 0xF, 0xF, true))
__device__ __forceinline__ float rowsum16(float x) { DPP_ADD(x, 0xB1); DPP_ADD(x, 0x4E); DPP_ADD(x, 0x141); DPP_ADD(x, 0x140); return x; }
__device__ __forceinline__ float rdlane(float x, int l) { return __builtin_bit_cast(float, __builtin_amdgcn_readlane(__builtin_bit_cast(int, x), l)); }
__device__ __forceinline__ float wave_sum(float v) { v = rowsum16(v); return (rdlane(v, 0) + rdlane(v, 16)) + (rdlane(v, 32) + rdlane(v, 48)); }
__device__ __forceinline__ float xlane(float x, int srclane) { return __builtin_bit_cast(float, __builtin_amdgcn_ds_bpermute(srclane << 2, __builtin_bit_cast(int, x))); }
__device__ __forceinline__ float fast_exp(float x) { return __builtin_amdgcn_exp2f(x * LOG2E); }
__device__ __forceinline__ float fast_sigmoid(float x) { return __builtin_amdgcn_rcpf(1.0f + fast_exp(-x)); }
__device__ __forceinline__ float fast_tanh(float x) { return 1.0f - 2.0f * __builtin_amdgcn_rcpf(fast_exp(2.0f * x) + 1.0f); }

enum { I_X = 0, I_NORMG, I_WIN, I_WOUT, I_MU, I_WRKV, I_RWO, I_W0, I_W1, I_W2, I_A0, I_A1, I_A2, I_G1, I_G2, I_KK, I_KA, I_RK, I_GNG, I_GNB, I_KVG, I_WKV, I_BKV, I_WQ, I_BQ, I_AWO, I_BO, I_SINK };
constexpr int PTAB_OFF = 131072;
__device__ __forceinline__ unsigned long long ldp(volatile LAS unsigned long long* t, int i) {
    const unsigned long long v = t[i];
    const unsigned lo = __builtin_amdgcn_readfirstlane((unsigned)v), hi = __builtin_amdgcn_readfirstlane((unsigned)(v >> 32));
    return ((unsigned long long)hi << 32) | lo;
}
#define INP(i) ((const float*)ldp(ptab, (i)))
#define WSP() ((unsigned char*)ldp(ptab, 29))
namespace pg8 {
constexpr int BM = 256, BK = 64, HALF = 128, HTB = HALF * BK * 2, STAGE_BYTES = 8 * HTB, NXCD = 8, WGM = 8;
__host__ __device__ __forceinline__ int lds_byte(int r, int c) { const int st = (r >> 4) * 2 + (c >> 5), rr = r & 15, cc = c & 31, ob = rr * 64 + cc * 2; return st * 1024 + (ob ^ (((ob >> 9) & 1) << 5)); }
__host__ __device__ __forceinline__ void stage_rc(int b, int& R, int& C) { const int st = b / 1024, sb = b % 1024, swz = sb ^ (((sb >> 9) & 1) << 5); R = (st >> 1) * 16 + swz / 64; C = (st & 1) * 32 + (swz % 64) / 2; }
__host__ __device__ __forceinline__ int perm32(int rho) { const int n = rho >> 4, i = rho & 15; return 8 * (i >> 2) + 4 * n + (i & 3); }

struct Unit { int pm, pn; };
struct Gemm { const bf16_t* A; const bf16_t* Bt; int M, N, K, lda; };

struct StaticOrder {
    int nM, nN, nwg, G, c;
    __device__ void init(int M, int N, int G_, int c_) { nM = M / BM; nN = N / BM; nwg = nM * nN; G = G_; c = c_; }
    __device__ bool next(int i, Unit& u) const {
        const long L = (long)i * G + c; if (L >= nwg) return false;
        int wgid = (int)L; { const int q = nwg / NXCD, r = nwg % NXCD, xcd = wgid % NXCD, off = wgid / NXCD; wgid = (xcd < r ? xcd * (q + 1) : r * (q + 1) + (xcd - r) * q) + off; }
        const int nig = WGM * nN, gid = wgid / nig, fm = gid * WGM, gsz = (nM - fm) < WGM ? (nM - fm) : WGM;
        u.pm = fm + ((wgid % nig) % gsz); u.pn = (wgid % nig) / gsz; return true;
    }
};

typedef f32x4 Acc[2][2][4][2];

template <class Job>
__device__ __forceinline__ void gemm_phase(LAS unsigned char* lds, const Gemm g, const StaticOrder& S, const Job& J) {
    int tid = threadIdx.x; asm volatile("" : "+v"(tid));
    const int wid = __builtin_amdgcn_readfirstlane(tid >> 6), lane = tid & 63, wr = wid >> 2, wc = wid & 3, fr = lane & 15, fq = lane >> 4;
    const int K = g.K, nt = K / BK;
    unsigned voffA[2], voffB[2];
#pragma unroll
    for (int i = 0; i < 2; ++i) { int R, C; stage_rc(tid * 16 + i * 8192, R, C); const int Rb = (R & ~31) + perm32(R & 31);
        voffA[i] = (unsigned)(R * g.lda + C) * 2u; voffB[i] = (unsigned)(Rb * K + C) * 2u; }
    const size_t kstep = (size_t)(BK * 2);
    const unsigned hstepA = (unsigned)(HALF * g.lda * 2), hstepB = (unsigned)(HALF * K * 2);
    const unsigned ldsw = (unsigned)wid * 1024u;
    const int aoff = lds_byte(wr * 64 + fr, fq * 8), boff = lds_byte(wc * 32 + fr, fq * 8);
#define PG8_SA(b, h) (((b) * 2 + (h)) * HTB)
#define PG8_SB(b, h) ((4 + (b) * 2 + (h)) * HTB)
#define PG8_STAGE(bufoff, gbase, voff) do { _Pragma("unroll") for (int _i = 0; _i < 2; ++_i) \
        __builtin_amdgcn_global_load_lds((const unsigned*)((const char*)(gbase) + (voff)[_i]), (LAS unsigned*)(lds + (bufoff) + ldsw + _i * 8192), 16, 0, 0); } while (0)
#define PG8_LDA(dst, b, h) do { _Pragma("unroll") for (int m = 0; m < 4; ++m) _Pragma("unroll") for (int k = 0; k < 2; ++k) dst[m][k] = *(const LAS bf16x8*)(lds + PG8_SA(b, h) + aoff + m * 2048 + k * 1024); } while (0)
#define PG8_LDB(dst, b, h) do { _Pragma("unroll") for (int n = 0; n < 2; ++n) _Pragma("unroll") for (int k = 0; k < 2; ++k) dst[n][k] = *(const LAS bf16x8*)(lds + PG8_SB(b, h) + boff + n * 2048 + k * 1024); } while (0)
#define PG8_MMA(ai, bj, At, Bt) do { __builtin_amdgcn_s_setprio(1); _Pragma("unroll") for (int m = 0; m < 4; ++m) _Pragma("unroll") for (int n = 0; n < 2; ++n) _Pragma("unroll") for (int k = 0; k < 2; ++k) \
        acc[ai][bj][m][n] = __builtin_amdgcn_mfma_f32_16x16x32_bf16(Bt[n][k], At[m][k], acc[ai][bj][m][n], 0, 0, 0); __builtin_amdgcn_s_setprio(0); } while (0)
#define PG8_WAIT_V(n) asm volatile("s_waitcnt vmcnt(" #n ")" ::: "memory")
#define PG8_WAIT_L(n) asm volatile("s_waitcnt lgkmcnt(" #n ")" ::: "memory")
#define PG8_BAR __builtin_amdgcn_s_barrier()
#define PG8_SCHED __builtin_amdgcn_sched_barrier(0)
    Unit cur, nxt; int ui = 0;
    if (!S.next(0, cur)) return;
    Acc acc;
#pragma unroll
    for (int a = 0; a < 2; ++a)
#pragma unroll
        for (int b = 0; b < 2; ++b)
#pragma unroll
            for (int m = 0; m < 4; ++m)
#pragma unroll
                for (int n = 0; n < 2; ++n) acc[a][b][m][n] = (f32x4){0.f, 0.f, 0.f, 0.f};
    bf16x8 At[4][2], B0[2][2], B1[2][2];
    const char* cA; const char* cB; J.ptrs(g, cur, cA, cB);
    PG8_STAGE(PG8_SB(0, 0), cB, voffB); PG8_STAGE(PG8_SB(0, 1), cB + hstepB, voffB); PG8_STAGE(PG8_SA(0, 0), cA, voffA); PG8_STAGE(PG8_SA(0, 1), cA + hstepA, voffA);
    if (wr == 1) PG8_BAR;
    PG8_WAIT_V(2); PG8_BAR;
    PG8_STAGE(PG8_SB(1, 0), cB + kstep, voffB); PG8_STAGE(PG8_SA(1, 0), cA + kstep, voffA); PG8_STAGE(PG8_SB(1, 1), cB + hstepB + kstep, voffB);
    PG8_WAIT_V(6); PG8_BAR;
    for (;;) {
        const bool has_next = S.next(ui + 1, nxt);
        const char* nA = cA; const char* nB = cB; if (has_next) J.ptrs(g, nxt, nA, nB);
        for (int t = 0; t < nt; t += 2) {
            const bool last = (t == nt - 2);
            const char* a1 = cA + (size_t)(t + 1) * kstep;
            const char* a2 = last ? nA : cA + (size_t)(t + 2) * kstep; const char* b2 = last ? nB : cB + (size_t)(t + 2) * kstep;
            const char* a3 = a2 + kstep; const char* b3 = b2 + kstep;
            PG8_LDB(B0, 0, 0); PG8_LDB(B1, 0, 1); PG8_SCHED; PG8_LDA(At, 0, 0); PG8_STAGE(PG8_SA(1, 1), a1 + hstepA, voffA);
            PG8_WAIT_V(8); PG8_WAIT_L(0); PG8_BAR; PG8_MMA(0, 0, At, B0); PG8_MMA(0, 1, At, B1); PG8_BAR; PG8_SCHED;
            PG8_LDA(At, 0, 1); PG8_STAGE(PG8_SB(0, 0), b2, voffB); PG8_STAGE(PG8_SB(0, 1), b2 + hstepB, voffB); PG8_STAGE(PG8_SA(0, 0), a2, voffA);
            PG8_WAIT_V(8); PG8_WAIT_L(0); PG8_BAR; PG8_MMA(1, 0, At, B0); PG8_MMA(1, 1, At, B1); PG8_BAR; PG8_SCHED;
            PG8_LDB(B0, 1, 0); PG8_LDB(B1, 1, 1); PG8_SCHED; PG8_LDA(At, 1, 0); PG8_STAGE(PG8_SA(0, 1), a2 + hstepA, voffA);
            PG8_WAIT_V(8); PG8_WAIT_L(0); PG8_BAR; PG8_MMA(0, 0, At, B0); PG8_MMA(0, 1, At, B1); PG8_BAR; PG8_SCHED;
            PG8_LDA(At, 1, 1); PG8_STAGE(PG8_SB(1, 0), b3, voffB); PG8_STAGE(PG8_SB(1, 1), b3 + hstepB, voffB); PG8_STAGE(PG8_SA(1, 0), a3, voffA);
            PG8_WAIT_V(8); PG8_WAIT_L(0); PG8_BAR; PG8_MMA(1, 0, At, B0); PG8_MMA(1, 1, At, B1); PG8_BAR; PG8_SCHED;
        }
        if (wr == 0) PG8_BAR;
        { int t2 = threadIdx.x; asm volatile("" : "+v"(t2));
          const int w2 = __builtin_amdgcn_readfirstlane(t2 >> 6), l2 = t2 & 63; J.epi(acc, cur, w2 >> 2, w2 & 3, l2 & 15, l2 >> 4); }
        if (!has_next) break;
#pragma unroll
        for (int a = 0; a < 2; ++a)
#pragma unroll
            for (int b = 0; b < 2; ++b)
#pragma unroll
                for (int m = 0; m < 4; ++m)
#pragma unroll
                    for (int n = 0; n < 2; ++n) acc[a][b][m][n] = (f32x4){0.f, 0.f, 0.f, 0.f};
        cur = nxt; cA = nA; cB = nB; ++ui;
        if (wr == 1) PG8_BAR;
    }
    PG8_WAIT_V(0);
    PG8_BAR;
#undef PG8_SA
#undef PG8_SB
#undef PG8_STAGE
#undef PG8_LDA
#undef PG8_LDB
#undef PG8_MMA
#undef PG8_WAIT_V
#undef PG8_WAIT_L
#undef PG8_BAR
#undef PG8_SCHED
}

__device__ __forceinline__ void epi_store_bf16(const Acc& acc, bf16_t* O, int ldc, int row0, int col0, const float* cbias  , float scale) {
    f32x4 bv[2][2];
#pragma unroll
    for (int bj = 0; bj < 2; ++bj)
#pragma unroll
        for (int n = 0; n < 2; ++n) bv[bj][n] = cbias ? *(const f32x4*)(cbias + bj * HALF + 4 * n) : (f32x4){0.f, 0.f, 0.f, 0.f};
#pragma unroll
    for (int ai = 0; ai < 2; ++ai)
#pragma unroll
        for (int m = 0; m < 4; ++m) { bf16_t* rowp = O + (size_t)(row0 + ai * HALF + m * 16) * ldc + col0;
#pragma unroll
            for (int bj = 0; bj < 2; ++bj) st_bf8(rowp + bj * HALF, (acc[ai][bj][m][0] + bv[bj][0]) * scale, (acc[ai][bj][m][1] + bv[bj][1]) * scale); }
}
__device__ __forceinline__ void epi_swiglu(const Acc& acc, bf16_t* H, int row0, int hcol0) {
#pragma unroll
    for (int ai = 0; ai < 2; ++ai)
#pragma unroll
        for (int m = 0; m < 4; ++m) { bf16_t* rowp = H + (size_t)(row0 + ai * HALF + m * 16) * FF_ + hcol0;
            f32x4 h[2];
#pragma unroll
            for (int n = 0; n < 2; ++n)
#pragma unroll
                for (int i = 0; i < 4; ++i) { const float gt = acc[ai][0][m][n][i], up = acc[ai][1][m][n][i]; h[n][i] = gt * fast_sigmoid(gt) * up; }
            st_bf8(rowp, h[0], h[1]); }
}

typedef volatile LAS unsigned long long* PTab;
__device__ __forceinline__ void std_ptrs(const Gemm& g, const Unit& u, const char*& a, const char*& b) {
    a = (const char*)g.A + (size_t)u.pm * BM * g.lda * 2; b = (const char*)g.Bt + (size_t)u.pn * BM * g.K * 2; }
struct JobStd {
    PTab ptab; unsigned o_off; int bias_idx; float scale;
    __device__ __forceinline__ void ptrs(const Gemm& g, const Unit& u, const char*& a, const char*& b) const { std_ptrs(g, u, a, b); }
    __device__ __forceinline__ void epi(const Acc& acc, const Unit& u, int wr, int wc, int fr, int fq) const {
        const int col0 = u.pn * BM + wc * 32 + 8 * fq;
        epi_store_bf16(acc, (bf16_t*)(WSP() + o_off), 1024, u.pm * BM + wr * 64 + fr, col0, bias_idx >= 0 ? INP(bias_idx) + col0 : nullptr, scale); }
};
struct JobSwi {
    PTab ptab;
    __device__ __forceinline__ void ptrs(const Gemm& g, const Unit& u, const char*& a, const char*& b) const { std_ptrs(g, u, a, b); }
    __device__ __forceinline__ void epi(const Acc& acc, const Unit& u, int wr, int wc, int fr, int fq) const {
        epi_swiglu(acc, (bf16_t*)(WSP() + WS_HID), u.pm * BM + wr * 64 + fr, 128 * u.pn + wc * 32 + 8 * fq); }
};
struct JobG3 {
    PTab ptab; int rowbase;
    __device__ __forceinline__ void ptrs(const Gemm& g, const Unit& u, const char*& a, const char*& b) const {
        const int blk = u.pn < 12 ? (u.pn >> 2) : (u.pn - 9);
        a = (const char*)g.A + (size_t)u.pm * BM * g.lda * 2 + (size_t)blk * 2048; b = (const char*)g.Bt + (size_t)u.pn * BM * g.K * 2; }
    __device__ __forceinline__ void epi(const Acc& acc, const Unit& u, int wr, int wc, int fr, int fq) const {
        const int row0 = rowbase + u.pm * BM + wr * 64 + fr;
        if (u.pn < 12) { epi_store_bf16(acc, (bf16_t*)(WSP() + WS_RKV), 3072, row0, u.pn * BM + wc * 32 + 8 * fq, nullptr, 1.0f); return; }
        const int kind = u.pn - 12;
        if (kind < 2 && wc >= 2) return;
        bf16_t* LD = (bf16_t*)(WSP() + WS_LD);
        const int dcol = (kind == 0 ? 0 : (kind == 1 ? 64 : 128)) + wc * 32 + 8 * fq;
#pragma unroll
        for (int ai = 0; ai < 2; ++ai)
#pragma unroll
            for (int m = 0; m < 4; ++m) { f32x4 v[2];
#pragma unroll
                for (int n = 0; n < 2; ++n)
#pragma unroll
                    for (int i = 0; i < 4; ++i) { const float x = acc[ai][0][m][n][i]; v[n][i] = kind == 0 ? fast_tanh(x) : (kind == 1 ? x : fast_sigmoid(x)); }
                st_bf8(LD + (size_t)(row0 + ai * HALF + m * 16) * 256 + dcol, v[0], v[1]); }
    }
};
struct JobG4 {
    PTab ptab;
    __device__ __forceinline__ void ptrs(const Gemm& g, const Unit& u, const char*& a, const char*& b) const { std_ptrs(g, u, a, b); }
    __device__ __forceinline__ void epi(const Acc& acc, const Unit& u, int wr, int wc, int fr, int fq) const {
        const int kind = u.pn >> 2, row0 = u.pm * BM + wr * 64 + fr, col0 = (u.pn & 3) * BM + wc * 32 + 8 * fq;
        unsigned char* ws = WSP();
        if (kind == 2) { epi_store_bf16(acc, (bf16_t*)(ws + WS_G), 1024, row0, col0, nullptr, 1.0f); return; }
        const float* bsrc = kind == 0 ? INP(I_W0) : INP(I_A0); bf16_t* O = (bf16_t*)(ws + (kind == 0 ? WS_DEC : WS_A));
        f32x4 bv[2][2];
#pragma unroll
        for (int bj = 0; bj < 2; ++bj)
#pragma unroll
            for (int n = 0; n < 2; ++n) bv[bj][n] = *(const f32x4*)(bsrc + col0 + bj * HALF + 4 * n);
#pragma unroll
        for (int ai = 0; ai < 2; ++ai)
#pragma unroll
            for (int m = 0; m < 4; ++m)
#pragma unroll
                for (int bj = 0; bj < 2; ++bj) { f32x4 v[2];
#pragma unroll
                    for (int n = 0; n < 2; ++n)
#pragma unroll
                        for (int i = 0; i < 4; ++i) { const float z = acc[ai][bj][m][n][i] + bv[bj][n][i];
                            if (kind == 0) { const float x = -z; const float sp = fmaxf(x, 0.f) + __logf(1.0f + fast_exp(-fabsf(x))); v[n][i] = -fast_exp(-sp - 0.5f); }
                            else v[n][i] = fast_sigmoid(z); }
                    st_bf8(O + (size_t)(row0 + ai * HALF + m * 16) * 1024 + col0 + bj * HALF, v[0], v[1]); }
    }
};
struct JobG8 {
    PTab ptab;
    __device__ __forceinline__ void ptrs(const Gemm& g, const Unit& u, const char*& a, const char*& b) const {
        const char* xa = (const char*)g.A + (size_t)u.pm * BM * g.lda * 2; const char* ws = (const char*)WSP();
        if (u.pn == 1) { a = ws + WS_WKV + (size_t)256 * 1024 * 2; b = xa; }
        else { a = xa; b = u.pn == 0 ? ws + WS_WKV : ws + WS_WIN + 2 * WIN_STRIDE + (size_t)(u.pn - 2) * BM * g.K * 2; } }
    __device__ __forceinline__ void epi(const Acc& acc, const Unit& u, int wr, int wc, int fr, int fq) const {
        const int row0 = u.pm * BM + wr * 64 + fr; unsigned char* ws = WSP();
        if (u.pn >= 2) { epi_swiglu(acc, (bf16_t*)(ws + WS_HID), row0, 128 * (u.pn - 2) + wc * 32 + 8 * fq); return; }
        const float* bkv = INP(I_BKV);
        if (u.pn == 0) { const int col0 = wc * 32 + 8 * fq; epi_store_bf16(acc, (bf16_t*)(ws + WS_KB), 256, row0, col0, bkv + col0, 1.0f); return; }
        bf16_t* VT = (bf16_t*)(ws + WS_VT);
        const int r0 = wr * 64 + fr, c0 = u.pm * BM + wc * 32 + 8 * fq;
#pragma unroll
        for (int ai = 0; ai < 2; ++ai)
#pragma unroll
            for (int m = 0; m < 4; ++m) { const int r = r0 + ai * HALF + m * 16; const float bb = bkv[256 + r];
#pragma unroll
                for (int bj = 0; bj < 2; ++bj) st_bf8(VT + (size_t)r * M_ + c0 + bj * HALF, acc[ai][bj][m][0] + bb, acc[ai][bj][m][1] + bb); }
    }
};
}

struct Args { const float* in[28]; float* out; unsigned char* ws; int stop; int pad; };

__device__ __forceinline__ void tr_item(const float* W, int N, int k0, int n0, bf16_t* dst  , int ldk, const float* gain  , LAS float* scr, int lane) {
    float v[32];
    const float* src = W + (size_t)(k0 + (lane >> 5)) * N + n0 + (lane & 31);
#pragma unroll
    for (int i = 0; i < 32; ++i) v[i] = src[(size_t)(2 * i) * N];
#pragma unroll
    for (int i = 0; i < 32; ++i) scr[(2 * i + (lane >> 5)) * 33 + (lane & 31)] = v[i];
    asm volatile("s_waitcnt lgkmcnt(0)" ::: "memory");
    const int c = lane & 7;
    f32x4 g0 = (f32x4){1.f, 1.f, 1.f, 1.f}, g1 = g0;
    if (gain) { g0 = *(const f32x4*)(gain + 8 * c); g1 = *(const f32x4*)(gain + 8 * c + 4); }
#pragma unroll
    for (int j = 0; j < 4; ++j) { const int n = (lane >> 3) + 8 * j; const LAS float* s = scr + (8 * c) * 33 + n;
        u32x4 o; o.x = cvt_pk_bf16(s[0 * 33] * g0[0], s[1 * 33] * g0[1]); o.y = cvt_pk_bf16(s[2 * 33] * g0[2], s[3 * 33] * g0[3]);
        o.z = cvt_pk_bf16(s[4 * 33] * g1[0], s[5 * 33] * g1[1]); o.w = cvt_pk_bf16(s[6 * 33] * g1[2], s[7 * 33] * g1[3]);
        *(u32x4*)(dst + (size_t)n * ldk + 8 * c) = o; }
    asm volatile("s_waitcnt lgkmcnt(0)" ::: "memory");
}

__device__ __forceinline__ float sumsq4(const f32x4 (&v)[4]) { float s = 0.f;
#pragma unroll
    for (int j = 0; j < 4; ++j) s += (v[j][0] * v[j][0] + v[j][1] * v[j][1]) + (v[j][2] * v[j][2] + v[j][3] * v[j][3]);
    return s; }


#define XB_TMO      128
#define XB_XCNT(j)  (256  + 64 * (j))
#define XB_XSUB(j)  (1280 + 64 * (j))
#define XB_XGEN(j)  (2304 + 64 * (j))
#define XB_TOP      3328
#define XB_TOPGEN   3392
#define XB_SPIN_CAP (1u << 20)
__device__ __forceinline__ unsigned xb_ld(unsigned* p)              { return __hip_atomic_load(p, __ATOMIC_RELAXED, __HIP_MEMORY_SCOPE_AGENT); }
__device__ __forceinline__ unsigned xb_add(unsigned* p, unsigned v) { return __hip_atomic_fetch_add(p, v, __ATOMIC_RELAXED, __HIP_MEMORY_SCOPE_AGENT); }
__device__ __forceinline__ unsigned xb_xcc_id() { return (unsigned)__builtin_amdgcn_s_getreg((3 << 11) | 20) & 0xFu; }
#define XB_SPIN(cond, bar) do { unsigned _sp = 0; while (cond) { __builtin_amdgcn_s_sleep(1); \
    if ((++_sp & 255u) == 0u) { if (xb_ld(&(bar)[XB_TMO])) break; if (_sp > XB_SPIN_CAP) { atomicAdd(&(bar)[XB_TMO], 1u); break; } } } } while (0)
struct XcdBarrier { unsigned* bar; unsigned x; volatile LAS unsigned* st; };
__device__ __forceinline__ XcdBarrier xcd_barrier_post(unsigned* bar, volatile LAS unsigned* st) {
    XcdBarrier b; b.bar = bar; b.x = xb_xcc_id(); b.st = st;
    if (threadIdx.x == 0) (void)xb_add(&bar[XB_XCNT(b.x)], 1u);
    return b;
}
__device__ __forceinline__ void xcd_barrier_complete(unsigned* bar, unsigned x, unsigned& nloc, unsigned& nx) {
    const unsigned G = gridDim.x * gridDim.y * gridDim.z;
    unsigned sum, cnt, mine, sp = 0u;
    for (;;) {
        sum = 0u; cnt = 0u; mine = 0u;
#pragma unroll
        for (unsigned j = 0; j < 16; ++j) { const unsigned c = xb_ld(&bar[XB_XCNT(j)]); sum += c; cnt += (c > 0u) ? 1u : 0u; mine = (j == x) ? c : mine; }
        if (sum == G) break;
        __builtin_amdgcn_s_sleep(1);
        if ((++sp & 255u) == 0u) { if (xb_ld(&bar[XB_TMO])) break; if (sp > XB_SPIN_CAP) { atomicAdd(&bar[XB_TMO], 1u); break; } }
    }
    nloc = mine > 0u ? mine : 1u; nx = cnt > 0u ? cnt : 1u;
}
__device__ __forceinline__ void xcd_barrier(const XcdBarrier& b) {
    asm volatile("s_waitcnt vmcnt(0)" ::: "memory");
    __syncthreads();
    if (threadIdx.x == 0) {
        unsigned* bar = b.bar;
        __builtin_amdgcn_s_waitcnt(0);
        unsigned nloc = b.st[0], nx = b.st[1];
        if (nloc == 0u) { xcd_barrier_complete(bar, b.x, nloc, nx); b.st[0] = nloc; b.st[1] = nx; }
        const unsigned old = xb_add(&bar[XB_XSUB(b.x)], 1u);
        const unsigned gen = old / nloc;
        if (old + 1u == (gen + 1u) * nloc) {
            __builtin_amdgcn_fence(__ATOMIC_RELEASE, "agent");
            asm volatile("s_waitcnt vmcnt(0)" ::: "memory");
            const unsigned og = xb_add(&bar[XB_TOP], 1u);
            const unsigned tg = og / nx;
            if (og + 1u == (tg + 1u) * nx) xb_add(&bar[XB_TOPGEN], 1u);
            else XB_SPIN(xb_ld(&bar[XB_TOPGEN]) == tg, bar);
            __builtin_amdgcn_fence(__ATOMIC_ACQUIRE, "agent");
            xb_add(&bar[XB_XGEN(b.x)], 1u);
            asm volatile("s_waitcnt vmcnt(0)" ::: "memory");
        } else {
            XB_SPIN(xb_ld(&bar[XB_XGEN(b.x)]) == gen, bar);
            __builtin_amdgcn_fence(__ATOMIC_ACQUIRE, "agent");
            asm volatile("s_waitcnt vmcnt(0)" ::: "memory");
        }
    }
    __syncthreads();
}

__device__ __forceinline__ void run_phase(const int ph, volatile LAS unsigned long long* ptab0, LAS unsigned char* lds, const bool dry = false) {
    {
        int tid = threadIdx.x; asm volatile("" : "+v"(tid));
        volatile LAS unsigned long long* ptab = ptab0; asm volatile("" : "+s"(ptab));
        int G = gridDim.x, bx = blockIdx.x; asm volatile("" : "+s"(G), "+s"(bx));
        const int lane = tid & 63, wave = __builtin_amdgcn_readfirstlane(tid >> 6);
        const int vcu = (G % 8 == 0) ? (bx % 8) * (G / 8) + bx / 8 : bx;
        const int gw = vcu * NWAVES + wave, NGW = G * NWAVES;
        unsigned char* ws = (unsigned char*)ldp(ptab, 29);
        float* HA = (float*)ldp(ptab, 28);
        const float* normg = INP(I_NORMG);
        bf16_t* F = (bf16_t*)(ws + WS_F); bf16_t* XN = (bf16_t*)(ws + WS_XN); bf16_t* HID = (bf16_t*)(ws + WS_HID);
        if (ph == 0) {
            LAS float* scr = (LAS float*)(lds + wave * 16384);
            constexpr int NITEMS = 20480;
            for (int it = gw; it < NITEMS; it += NGW) {
                int r = it; const float* W; int N; bf16_t* dst; int ldk; const float* gain = nullptr; int mode = 0;
                if (r < 11264) { const int f = r / 2816; r -= f * 2816; W = INP(I_WIN) + (size_t)f * 1024 * 5632; N = 5632; dst = (bf16_t*)(ws + WS_WIN + f * WIN_STRIDE); ldk = 1024; mode = 1;
                    gain = normg + ((f >> 1) * 6 + ((f & 1) ? 4 : 0)) * 1024; }
                else if ((r -= 11264) < 5632) { const int f = r / 1408; r -= f * 1408; W = INP(I_WOUT) + (size_t)f * 2816 * 1024; N = 1024; dst = (bf16_t*)(ws + WS_WOUT + f * WOUT_STRIDE); ldk = 2816; }
                else if ((r -= 5632) < 1536) { const int c = r / 512; r -= c * 512; W = INP(I_WRKV) + (size_t)c * 1024 * 1024; N = 1024; dst = (bf16_t*)(ws + WS_B3) + (size_t)c * 1024 * 1024; ldk = 1024; }
                else if ((r -= 1536) < 32) { W = INP(I_W1); N = 64; dst = (bf16_t*)(ws + WS_B3) + (size_t)3072 * 1024; ldk = 1024; }
                else if ((r -= 32) < 32) { W = INP(I_A1); N = 64; dst = (bf16_t*)(ws + WS_B3) + (size_t)3328 * 1024; ldk = 1024; }
                else if ((r -= 32) < 64) { W = INP(I_G1); N = 128; dst = (bf16_t*)(ws + WS_B3) + (size_t)3584 * 1024; ldk = 1024; }
                else if ((r -= 64) < 32) { W = INP(I_W2); N = 1024; dst = (bf16_t*)(ws + WS_LUP); ldk = 256; }
                else if ((r -= 32) < 32) { W = INP(I_A2); N = 1024; dst = (bf16_t*)(ws + WS_LUP) + (size_t)1024 * 256 + 64; ldk = 256; }
                else if ((r -= 32) < 64) { W = INP(I_G2); N = 1024; dst = (bf16_t*)(ws + WS_LUP) + (size_t)2048 * 256 + 128; ldk = 256; }
                else if ((r -= 64) < 512) { W = INP(I_RWO); N = 1024; dst = (bf16_t*)(ws + WS_RWO); ldk = 1024; }
                else if ((r -= 512) < 256) { W = INP(I_WKV); N = 512; dst = (bf16_t*)(ws + WS_WKV); ldk = 1024; gain = INP(I_KVG); }
                else if ((r -= 256) < 512) { W = INP(I_WQ); N = 1024; dst = (bf16_t*)(ws + WS_WQ); ldk = 1024; gain = normg + (6 + 2) * 1024; }
                else { r -= 512; W = INP(I_AWO); N = 1024; dst = (bf16_t*)(ws + WS_AWO); ldk = 1024; }
                const int nblk = N / 32, kb = r / nblk, nb = r % nblk, k0 = 64 * kb, n0 = 32 * nb;
                int drow = n0;
                if (mode == 1) drow = n0 < FF_ ? (n0 >> 7) * 256 + (n0 & 127) : ((n0 - FF_) >> 7) * 256 + 128 + ((n0 - FF_) & 127);
                tr_item(W, N, k0, n0, dst + (size_t)drow * ldk + k0, ldk, gain ? gain + k0 : nullptr, scr, lane);
            }
            const float* x = INP(I_X);
            for (int row = gw; row < M_; row += NGW) {
                f32x4 v[4];
#pragma unroll
                for (int j = 0; j < 4; ++j) v[j] = *(const f32x4*)(x + (size_t)row * D_ + 4 * lane + 256 * j);
                const float rs = rsqrtf(wave_sum(sumsq4(v)) * (1.0f / D_) + RMS_EPS);
#pragma unroll
                for (int j = 0; j < 4; ++j) st_bf4(XN + (size_t)row * D_ + 4 * lane + 256 * j, v[j] * rs);
            }
        }
        else if (ph == 1 || ph == 12 || ph == 22) {
            const int f = ph == 1 ? 0 : (ph == 12 ? 1 : 3);
            pg8::Gemm g{XN, (const bf16_t*)(ws + WS_WIN + f * WIN_STRIDE), M_, 2 * FF_, D_, D_};
            pg8::StaticOrder S; S.init(M_, 2 * FF_, G, bx);
            pg8::JobSwi J{ptab};
            pg8::gemm_phase<pg8::JobSwi>(lds, g, S, J);
        }
        else if (ph == 2 || ph == 13 || ph == 16 || ph == 23 || ph == 10 || ph == 18 || ph == 20) {
            pg8::Gemm g; pg8::JobStd J;
            if (ph == 10) { g = pg8::Gemm{(const bf16_t*)(ws + WS_YG), (const bf16_t*)(ws + WS_RWO), M_, D_, D_, D_}; J = pg8::JobStd{ptab, (unsigned)WS_F, -1, 1.0f}; }
            else if (ph == 18) { g = pg8::Gemm{XN, (const bf16_t*)(ws + WS_WQ), M_, D_, D_, D_}; J = pg8::JobStd{ptab, (unsigned)WS_Q, I_BQ, QSCALE}; }
            else if (ph == 20) { g = pg8::Gemm{(const bf16_t*)(ws + WS_O), (const bf16_t*)(ws + WS_AWO), M_, D_, D_, D_}; J = pg8::JobStd{ptab, (unsigned)WS_F, I_BO, 1.0f}; }
            else { const int f = ph == 2 ? 0 : (ph == 13 ? 1 : (ph == 16 ? 2 : 3));
                g = pg8::Gemm{HID, (const bf16_t*)(ws + WS_WOUT + f * WOUT_STRIDE), M_, D_, FF_, FF_}; J = pg8::JobStd{ptab, (unsigned)WS_F, -1, 1.0f}; }
            pg8::StaticOrder S; S.init(M_, D_, G, bx);
            pg8::gemm_phase<pg8::JobStd>(lds, g, S, J);
        }
        else if (ph == 3 || ph == 5) {
            const int hb = ph == 3 ? 0 : 1;
            LAS float* mus = (LAS float*)lds;
            for (int e = tid; e < 6 * 1024; e += NTHR) { const int c = e >> 10; const int src = c == 0 ? 0 : (c == 1 ? 2 : (c == 2 ? 3 : (c == 3 ? 1 : c))); mus[e] = INP(I_MU)[src * 1024 + (e & 1023)]; }
            __syncthreads();
            const float* x = INP(I_X); bf16_t* X6 = (bf16_t*)(ws + WS_X6);
            f32x4 g1[4], g2[4];
#pragma unroll
            for (int j = 0; j < 4; ++j) { g1[j] = *(const f32x4*)(normg + 1 * 1024 + 4 * lane + 256 * j) * (dry ? 0.0f : 0.5f); g2[j] = *(const f32x4*)(normg + 2 * 1024 + 4 * lane + 256 * j); }
            const int r0 = 8192 * hb + 4 * gw;
            f32x4 up[4];
#pragma unroll
            for (int j = 0; j < 4; ++j) up[j] = (f32x4){0.f, 0.f, 0.f, 0.f};
            for (int rr = ((r0 & (T_ - 1)) ? -1 : 0); rr < 4; ++rr) {
                const int row = r0 + rr;
                f32x4 fv[4], h[4];
#pragma unroll
                for (int j = 0; j < 4; ++j) { fv[j] = ld_bf4(F + (size_t)row * D_ + 4 * lane + 256 * j); h[j] = *(const f32x4*)(x + (size_t)row * D_ + 4 * lane + 256 * j); }
                const float rs1 = rsqrtf(wave_sum(sumsq4(fv)) * (1.0f / D_) + RMS_EPS);
#pragma unroll
                for (int j = 0; j < 4; ++j) h[j] = h[j] + fv[j] * rs1 * g1[j];
                const float rs2 = rsqrtf(wave_sum(sumsq4(h)) * (1.0f / D_) + RMS_EPS);
                if (rr >= 0) {
#pragma unroll
                    for (int j = 0; j < 4; ++j) *(f32x4*)(HA + (size_t)row * D_ + 4 * lane + 256 * j) = h[j];
                }
#pragma unroll
                for (int j = 0; j < 4; ++j) { const f32x4 u = h[j] * rs2 * g2[j];
                    if (rr >= 0) { const f32x4 xx = up[j] - u; bf16_t* dstp = X6 + (size_t)(row - 8192 * hb) * 6144 + 4 * lane + 256 * j;
#pragma unroll
                        for (int c = 0; c < 6; ++c) st_bf4(dstp + c * 1024, u + xx * *(const LAS f32x4*)(mus + c * 1024 + 4 * lane + 256 * j)); }
                    up[j] = u; }
            }
        }
        else if (ph == 4 || ph == 6) {
            const int hb = ph == 4 ? 0 : 1;
            pg8::Gemm g{(const bf16_t*)(ws + WS_X6), (const bf16_t*)(ws + WS_B3), 8192, 3840, D_, 6144};
            pg8::StaticOrder S; S.init(8192, 3840, G, bx);
            pg8::JobG3 J{ptab, 8192 * hb};
            pg8::gemm_phase<pg8::JobG3>(lds, g, S, J);
        }
        else if (ph == 7) {
            pg8::Gemm g{(const bf16_t*)(ws + WS_LD), (const bf16_t*)(ws + WS_LUP), M_, 3072, 256, 256};
            pg8::StaticOrder S; S.init(M_, 3072, G, bx);
            pg8::JobG4 J{ptab};
            pg8::gemm_phase<pg8::JobG4>(lds, g, S, J);
        }
        else if (ph == 8) {
            constexpr int TC = 32, NCH = T_ / TC;
            constexpr int BUFB = TC * 1280 + TC * 64 + TC * 64;
            const int bh = vcu >> 2, rq = vcu & 3, bb = bh >> 4, hh = bh & 15;
            const bf16_t* RKV = (const bf16_t*)(ws + WS_RKV); const bf16_t* DEC = (const bf16_t*)(ws + WS_DEC); const bf16_t* Aa = (const bf16_t*)(ws + WS_A);
            float* Y = (float*)(ws + WS_Y);
            const size_t rowbase = (size_t)bb * T_;
            if (vcu < 256) {
            if (wave < 4) {
                const int ri = lane >> 4, j4 = lane & 15;
                float S0 = 0.f, S1 = 0.f, S2 = 0.f, S3 = 0.f;
                __syncthreads();
                for (int ci = 0; ci < NCH; ++ci) {
                    const LAS unsigned char* buf = lds + (ci & 1) * BUFB;
                    const LAS float* vb = (const LAS float*)(buf + TC * 1280) + wave * 4 + ri;
                    LAS float* yb = (LAS float*)(buf + TC * 1280 + TC * 64) + wave * 4 + ri;
#pragma unroll 8
                    for (int s = 0; s < TC; ++s) {
                        const LAS unsigned char* p = buf + s * 1280 + j4 * 16;
                        const f32x4 nk = *(const LAS f32x4*)(p), w = *(const LAS f32x4*)(p + 256), b = *(const LAS f32x4*)(p + 512), k = *(const LAS f32x4*)(p + 768), r = *(const LAS f32x4*)(p + 1024);
                        const float v = vb[s * 16];
                        float sa = (S0 * nk[0] + S1 * nk[1]) + (S2 * nk[2] + S3 * nk[3]);
                        sa = rowsum16(sa);
                        S0 = S0 * w[0] + (sa * b[0] + v * k[0]); S1 = S1 * w[1] + (sa * b[1] + v * k[1]);
                        S2 = S2 * w[2] + (sa * b[2] + v * k[2]); S3 = S3 * w[3] + (sa * b[3] + v * k[3]);
                        float y = (S0 * r[0] + S1 * r[1]) + (S2 * r[2] + S3 * r[3]);
                        y = rowsum16(y);
                        if (j4 == 0) yb[s * 16] = y;
                    }
                    __syncthreads();
                }
            } else {
                const int lw = wave - 4, ss = lane >> 4, j4 = lane & 15;
                const f32x4 kk4 = *(const f32x4*)(INP(I_KK) + hh * 64 + 4 * j4), ka4 = *(const f32x4*)(INP(I_KA) + hh * 64 + 4 * j4);
                const int e = lw * 128 + lane * 2, es = e >> 4, ei = e & 15;
                for (int ci = -1; ci < NCH; ++ci) {
                    if (ci > 0) {
                        const LAS unsigned char* buf = lds + ((ci - 1) & 1) * BUFB;
                        const f32x2 yv = *(const LAS f32x2*)(buf + TC * 1280 + TC * 64 + (es * 16 + ei) * 4);
                        *(f32x2*)(Y + (rowbase + (size_t)(ci - 1) * TC + es) * D_ + hh * 64 + rq * 16 + ei) = yv;
                    }
                    if (ci + 1 < NCH) {
                        LAS unsigned char* buf = lds + ((ci + 1) & 1) * BUFB;
                        const size_t t0 = rowbase + (size_t)(ci + 1) * TC;
#pragma unroll
                        for (int it = 0; it < 2; ++it) {
                            const int s = lw * 8 + it * 4 + ss; const size_t row = t0 + s;
                            const f32x4 r4 = ld_bf4(RKV + row * 3072 + hh * 64 + 4 * j4), k4 = ld_bf4(RKV + row * 3072 + 1024 + hh * 64 + 4 * j4);
                            const f32x4 a4 = ld_bf4(Aa + row * D_ + hh * 64 + 4 * j4), d4 = ld_bf4(DEC + row * D_ + hh * 64 + 4 * j4);
                            const f32x4 kk = k4 * kk4;
                            float q = (kk[0] * kk[0] + kk[1] * kk[1]) + (kk[2] * kk[2] + kk[3] * kk[3]);
                            q = rowsum16(q);
                            const float inv = 1.0f / fmaxf(sqrtf(q), 1e-12f);
                            const f32x4 kn = kk * inv;
                            f32x4 wv; wv[0] = fast_exp(d4[0]); wv[1] = fast_exp(d4[1]); wv[2] = fast_exp(d4[2]); wv[3] = fast_exp(d4[3]);
                            LAS unsigned char* p = buf + s * 1280 + j4 * 16;
                            *(LAS f32x4*)(p) = -kn; *(LAS f32x4*)(p + 256) = wv; *(LAS f32x4*)(p + 512) = kn * a4;
                            *(LAS f32x4*)(p + 768) = k4 * (1.0f + (a4 - 1.0f) * ka4); *(LAS f32x4*)(p + 1024) = r4;
                        }
                        const unsigned vv = *(const unsigned*)(RKV + (t0 + es) * 3072 + 2048 + hh * 64 + rq * 16 + ei);
                        *(LAS f32x2*)(buf + TC * 1280 + (es * 16 + ei) * 4) = (f32x2){bf_lo(vv), bf_hi(vv)};
                    }
                    __syncthreads();
                }
                {
                    const LAS unsigned char* buf = lds + ((NCH - 1) & 1) * BUFB;
                    const f32x2 yv = *(const LAS f32x2*)(buf + TC * 1280 + TC * 64 + (es * 16 + ei) * 4);
                    *(f32x2*)(Y + (rowbase + (size_t)(NCH - 1) * TC + es) * D_ + hh * 64 + rq * 16 + ei) = yv;
                }
            }
            }
        }
        else if (ph == 9) {
            const bf16_t* RKV = (const bf16_t*)(ws + WS_RKV); const bf16_t* Aa = (const bf16_t*)(ws + WS_A); const bf16_t* Gg = (const bf16_t*)(ws + WS_G);
            const float* Y = (const float*)(ws + WS_Y); bf16_t* YG = (bf16_t*)(ws + WS_YG);
            for (int row = gw; row < M_; row += NGW) {
#pragma unroll
                for (int j = 0; j < 4; ++j) {
                    const int col = 4 * lane + 256 * j;
                    const f32x4 y = *(const f32x4*)(Y + (size_t)row * D_ + col);
                    const f32x4 r4 = ld_bf4(RKV + (size_t)row * 3072 + col), k4 = ld_bf4(RKV + (size_t)row * 3072 + 1024 + col), v4 = ld_bf4(RKV + (size_t)row * 3072 + 2048 + col);
                    const f32x4 a4 = ld_bf4(Aa + (size_t)row * D_ + col), g4 = ld_bf4(Gg + (size_t)row * D_ + col);
                    const f32x4 ka = *(const f32x4*)(INP(I_KA) + col), rk = *(const f32x4*)(INP(I_RK) + col);
                    const f32x4 gg = *(const f32x4*)(INP(I_GNG) + col), gb = *(const f32x4*)(INP(I_GNB) + col);
                    const float mean = rowsum16((y[0] + y[1]) + (y[2] + y[3])) * (1.0f / 64.0f);
                    const f32x4 dy = y - mean;
                    const float var = rowsum16((dy[0] * dy[0] + dy[1] * dy[1]) + (dy[2] * dy[2] + dy[3] * dy[3])) * (1.0f / 64.0f);
                    const float rstd = rsqrtf(var + GN_EPS);
                    const f32x4 kp = k4 * (1.0f + (a4 - 1.0f) * ka);
                    const f32x4 t = r4 * kp * rk;
                    const float bon = rowsum16((t[0] + t[1]) + (t[2] + t[3]));
                    st_bf4(YG + (size_t)row * D_ + col, (dy * rstd * gg + gb + v4 * bon) * g4);
                }
            }
        }
        else if (ph == 11 || ph == 14 || ph == 17 || ph == 21 || ph == 24) {
            const int gi = ph == 11 ? 3 : (ph == 14 ? 5 : (ph == 17 ? 7 : (ph == 21 ? 9 : 11)));
            const float c = dry ? 0.0f : ((ph == 11 || ph == 21) ? 1.0f : 0.5f);
            const bool want_xn = ph != 24;
            f32x4 ga[4];
#pragma unroll
            for (int j = 0; j < 4; ++j) ga[j] = *(const f32x4*)(normg + gi * 1024 + 4 * lane + 256 * j) * c;
            for (int row = gw; row < M_; row += NGW) {
                f32x4 fv[4], h[4];
#pragma unroll
                for (int j = 0; j < 4; ++j) { fv[j] = ld_bf4(F + (size_t)row * D_ + 4 * lane + 256 * j); h[j] = *(const f32x4*)(HA + (size_t)row * D_ + 4 * lane + 256 * j); }
                const float rs1 = rsqrtf(wave_sum(sumsq4(fv)) * (1.0f / D_) + RMS_EPS);
#pragma unroll
                for (int j = 0; j < 4; ++j) { h[j] = h[j] + fv[j] * rs1 * ga[j]; *(f32x4*)(HA + (size_t)row * D_ + 4 * lane + 256 * j) = h[j]; }
                if (want_xn) {
                    const float rs2 = rsqrtf(wave_sum(sumsq4(h)) * (1.0f / D_) + RMS_EPS);
#pragma unroll
                    for (int j = 0; j < 4; ++j) st_bf4(XN + (size_t)row * D_ + 4 * lane + 256 * j, h[j] * rs2);
                }
            }
        }
        else if (ph == 15) {
            pg8::Gemm g{XN, nullptr, M_, 2 * FF_ + 512, D_, D_};
            pg8::StaticOrder S; S.init(M_, 2 * FF_ + 512, G, bx);
            pg8::JobG8 J{ptab};
            pg8::gemm_phase<pg8::JobG8>(lds, g, S, J);
        }
        else if (ph == 19) {
            const bf16_t* Q = (const bf16_t*)(ws + WS_Q); const bf16_t* KB = (const bf16_t*)(ws + WS_KB); const bf16_t* VT = (const bf16_t*)(ws + WS_VT); bf16_t* O = (bf16_t*)(ws + WS_O);
            LAS bf16_t* Ks = (LAS bf16_t*)lds;
            LAS bf16_t* Vs = (LAS bf16_t*)(lds + 36864);
            const int fr = lane & 15, fq = lane >> 4;
            for (int unit = vcu; unit < 512; unit += G) {
                const int nb = unit & 31, kvh = (unit >> 5) & 3, bb = unit >> 7;
                const size_t rowbase = (size_t)bb * T_; const int t0 = 128 * (nb - 1);
                __syncthreads();
#pragma unroll
                for (int i = 0; i < 4; ++i) { const int c = tid + NTHR * i; const int key = c >> 3, part = c & 7;
                    u32x4 v = (u32x4){0u, 0u, 0u, 0u};
                    if (nb > 0 || key >= 128) v = *(const u32x4*)(KB + (rowbase + t0 + key) * 256 + kvh * 64 + part * 8);
                    *(LAS u32x4*)(Ks + key * 72 + part * 8) = v; }
#pragma unroll
                for (int i = 0; i < 4; ++i) { const int c = tid + NTHR * i; const int d = c >> 5, part = c & 31;
                    u32x4 v = (u32x4){0u, 0u, 0u, 0u};
                    if (nb > 0 || part >= 16) v = *(const u32x4*)(VT + (size_t)(kvh * 64 + d) * M_ + rowbase + t0 + part * 8);
                    *(LAS u32x4*)(Vs + d * 264 + part * 8) = v; }
                __syncthreads();
                const int gi = wave >> 1, qh = wave & 1, hq = kvh * 4 + gi;
                const float sink = INP(I_SINK)[hq] * LOG2E;
                for (int qt = 0; qt < 4; ++qt) {
                    const int qo = 64 * qh + 16 * qt, kt0 = qo >> 4;
                    const size_t qrow = rowbase + 128 * nb + qo + fr;
                    bf16x8 bq[2];
#pragma unroll
                    for (int ks = 0; ks < 2; ++ks) bq[ks] = *(const bf16x8*)(Q + qrow * D_ + hq * 64 + 32 * ks + 8 * fq);
                    f32x4 sc[9];
#pragma unroll
                    for (int i = 0; i < 9; ++i) { sc[i] = (f32x4){0.f, 0.f, 0.f, 0.f};
#pragma unroll
                        for (int ks = 0; ks < 2; ++ks) { const bf16x8 ka = *(const LAS bf16x8*)(Ks + (16 * (kt0 + i) + fr) * 72 + 32 * ks + 8 * fq);
                            sc[i] = __builtin_amdgcn_mfma_f32_16x16x32_bf16(ka, bq[ks], sc[i], 0, 0, 0); } }
                    const int qw = 128 + qo + fr;
                    float mx = sink;
#pragma unroll
                    for (int i = 0; i < 9; ++i)
#pragma unroll
                        for (int r = 0; r < 4; ++r) { const int kw = 16 * (kt0 + i) + 4 * fq + r; const bool ok = (kw <= qw) && (qw - kw < 128) && (nb > 0 || kw >= 128);
                            sc[i][r] = ok ? sc[i][r] : -1e30f; mx = fmaxf(mx, sc[i][r]); }
                    mx = fmaxf(mx, xlane(mx, lane ^ 16)); mx = fmaxf(mx, xlane(mx, lane ^ 32));
                    float ls = 0.f; bf16x4 pb[9];
#pragma unroll
                    for (int i = 0; i < 9; ++i) { f32x4 p;
#pragma unroll
                        for (int r = 0; r < 4; ++r) { p[r] = __builtin_amdgcn_exp2f(sc[i][r] - mx); ls += p[r]; }
                        u32x2 w; w.x = cvt_pk_bf16(p[0], p[1]); w.y = cvt_pk_bf16(p[2], p[3]); pb[i] = __builtin_bit_cast(bf16x4, w); }
                    ls += xlane(ls, lane ^ 16); ls += xlane(ls, lane ^ 32);
                    ls += __builtin_amdgcn_exp2f(sink - mx);
                    const float inv = 1.0f / ls;
#pragma unroll
                    for (int dt = 0; dt < 4; ++dt) { f32x4 o = (f32x4){0.f, 0.f, 0.f, 0.f};
#pragma unroll
                        for (int i = 0; i < 9; ++i) { const bf16x4 va = *(const LAS bf16x4*)(Vs + (16 * dt + fr) * 264 + 16 * (kt0 + i) + 4 * fq);
                            o = __builtin_amdgcn_mfma_f32_16x16x16bf16_1k(va, pb[i], o, 0, 0, 0); }
                        st_bf4(O + qrow * D_ + hq * 64 + 16 * dt + 4 * fq, o * inv); }
                }
            }
        }
    }
}
__global__ void __launch_bounds__(NTHR, 2) fwd_kernel(Args args) {
    extern __shared__ __attribute__((aligned(16))) unsigned char lds_raw[];
    cg::grid_group grid = cg::this_grid();
    LAS unsigned char* lds = (LAS unsigned char*)lds_raw;
    const int tid0 = threadIdx.x;
    volatile LAS unsigned long long* ptab0 = (volatile LAS unsigned long long*)(lds + PTAB_OFF);
    { volatile LAS unsigned long long* ptab = ptab0;
    if (tid0 == 0) {
#pragma unroll
        for (int i = 0; i < 28; ++i) ptab[i] = (unsigned long long)args.in[i];
        ptab[28] = (unsigned long long)args.out; ptab[29] = (unsigned long long)args.ws; ptab[30] = (unsigned long long)args.stop;
    }
    if (tid0 < 2) ((volatile LAS unsigned*)(lds + PTAB_OFF + 512))[tid0] = 0u;
    __syncthreads(); }
    const int nph = (int)ldp(ptab0, 30);
    const XcdBarrier xbar = xcd_barrier_post((unsigned*)args.ws, (volatile LAS unsigned*)(lds + PTAB_OFF + 512));
    if (nph > 1000) grid.sync();
#define GSYNC() do { XcdBarrier xb_; xb_.bar = (unsigned*)ldp(ptab0, 29); xb_.x = xb_xcc_id(); xb_.st = (volatile LAS unsigned*)(lds + PTAB_OFF + 512); xcd_barrier(xb_); } while (0)
#ifndef PROBE_MASK
#define PROBE_MASK 0x0u
#endif
#ifndef PROBE_SYNC
#define PROBE_SYNC 0
#endif
#define RP(k) if (nph <= (k)) return; if (PROBE_SYNC) GSYNC(); if ((PROBE_MASK >> (k)) & 1u) { run_phase((k), ptab0, lds, true); GSYNC(); } run_phase((k), ptab0, lds); if (nph > (k) + 1) GSYNC();
    RP(0) RP(1) RP(2) RP(3) RP(4) RP(5) RP(6) RP(7) RP(8) RP(9) RP(10) RP(11) RP(12) RP(13) RP(14) RP(15) RP(16) RP(17) RP(18) RP(19) RP(20) RP(21) RP(22) RP(23) RP(24)
#undef RP
}

extern "C" void kernel_launch(void* const* d_in, const int* in_sizes, int n_in, void* d_out, int out_size, void* d_ws, size_t ws_size, hipStream_t stream) {
    static int grid = 0;
    if (grid == 0) {
        if (n_in != 28 || out_size != M_ * D_ || ws_size < WS_END) { fprintf(stderr, "kernel_launch: unexpected problem (n_in %d out %d ws %zu)\n", n_in, out_size, ws_size); grid = -1; return; }
        int dev = 0, cus = 0, per_cu = 0;
        (void)hipGetDevice(&dev); (void)hipDeviceGetAttribute(&cus, hipDeviceAttributeMultiprocessorCount, dev);
        if (hipFuncSetAttribute((const void*)fwd_kernel, hipFuncAttributeMaxDynamicSharedMemorySize, LDS_BYTES) != hipSuccess) { fprintf(stderr, "kernel_launch: hipFuncSetAttribute failed\n"); grid = -1; return; }
        if (hipOccupancyMaxActiveBlocksPerMultiprocessor(&per_cu, (const void*)fwd_kernel, NTHR, LDS_BYTES) != hipSuccess || per_cu < 1) { fprintf(stderr, "kernel_launch: occupancy query says %d\n", per_cu); per_cu = 1; }
        (void)hipGetLastError();
        grid = cus * 1;
        if (grid > 256) grid = 256;
    }
    if (grid < 0) return;
    (void)hipMemsetAsync(d_ws, 0, 65536, stream);
    (void)hipMemsetAsync((char*)d_ws + WS_B3 + (size_t)3072 * 1024 * 2, 0, (size_t)768 * 1024 * 2, stream);
    (void)hipMemsetAsync((char*)d_ws + WS_LUP, 0, (size_t)3072 * 256 * 2, stream);
    Args a{};
    for (int i = 0; i < 28; ++i) a.in[i] = (const float*)d_in[i];
    a.out = (float*)d_out; a.ws = (unsigned char*)d_ws; a.stop = 25; a.pad = 0;
    void* kargs[] = {&a};
    hipError_t e = hipLaunchCooperativeKernel((const void*)fwd_kernel, dim3(grid), dim3(NTHR), kargs, LDS_BYTES, stream);
    if (e != hipSuccess) fprintf(stderr, "kernel_launch: cooperative launch failed: %s (grid %d)\n", hipGetErrorString(e), grid);
}
```
